# Optimizing an MI355X kernel written in HIP

```python
import jax, jax.numpy as jnp
from jax import lax
import numpy as np

D_MODEL = 1024
BATCH = 4
SEQ = 8192
DEPTH = 2

GRID_W = 64
CTX_LEN = 256
ROPE_BASE = 10000.0
ALPHA = (2 * DEPTH) ** 0.25
BETA = (8 * DEPTH) ** -0.25
N_EVEN = (DEPTH + 1) // 2
N_ODD = DEPTH // 2
Q_BLOCK = 128
EPS = 1e-5
NEG = -1e30

H_MLA = 8
MLA_NOPE = 64
MLA_ROPE = 32
MLA_V = 64
MLA_Q_LORA = 384
MLA_KV_LORA = 256

H_RET = 4
RET_DK = 128
RET_DV = 128
RET_CHUNK = 128

AB_IN = MLA_Q_LORA + MLA_KV_LORA + MLA_ROPE + 2 * H_RET * RET_DK + 2 * H_RET * RET_DV
AB_MIX = H_MLA * MLA_V + H_RET * RET_DV

H_M = 8
M_DK = 64
M_DV = 128
M_CHUNK = 64
CONV_W = 3
M_IN = 2 * H_M * M_DK + 2 * H_M * M_DV + 4 * H_M
M_MIX = H_M * M_DV

D_FF = -(-8 * D_MODEL // (3 * 256)) * 256

kernel_name = 'hybrid_mla_retention_mlstm_dit'


def _layer_norm(x, g, b):
    xf = x.astype(jnp.float32)
    mu = jnp.mean(xf, axis=-1, keepdims=True)
    var = jnp.mean(jnp.square(xf - mu), axis=-1, keepdims=True)
    return ((xf - mu) * lax.rsqrt(var + EPS) * g + b).astype(x.dtype)


def _head_norm(x):
    xf = x.astype(jnp.float32)
    mu = jnp.mean(xf, axis=-1, keepdims=True)
    var = jnp.mean(jnp.square(xf - mu), axis=-1, keepdims=True)
    return (xf - mu) * lax.rsqrt(var + EPS)


def _rms_norm(x, g):
    xf = x.astype(jnp.float32)
    return (xf * lax.rsqrt(jnp.mean(jnp.square(xf), axis=-1, keepdims=True) + EPS) * g).astype(x.dtype)


def _modulate(x, shift, scale):
    return x * (1.0 + scale) + shift


def _swiglu(h, w_in, w_out):
    up, gate = jnp.split(h @ w_in, 2, axis=-1)
    return (jax.nn.silu(gate) * up) @ w_out


def _axial_tables(n, d):
    rows = n // GRID_W
    row = jnp.repeat(jnp.arange(rows, dtype=jnp.float32), GRID_W)
    col = jnp.tile(jnp.arange(GRID_W, dtype=jnp.float32), rows)
    da = d // 2
    inv = ROPE_BASE ** (-jnp.arange(0, da, 2, dtype=jnp.float32) / da)
    ar = row[:, None] * inv
    ac = col[:, None] * inv
    return (jnp.cos(ar), jnp.sin(ar), jnp.cos(ac), jnp.sin(ac))


def _rot_half(x, cos, sin):
    x1, x2 = jnp.split(x, 2, axis=-1)
    cos = cos[:, None, :]
    sin = sin[:, None, :]
    return jnp.concatenate([x1 * cos - x2 * sin, x1 * sin + x2 * cos], axis=-1)


def _rope_2d(x, tabs):
    cos_r, sin_r, cos_c, sin_c = tabs
    xr, xc = jnp.split(x, 2, axis=-1)
    return jnp.concatenate([_rot_half(xr, cos_r, sin_r), _rot_half(xc, cos_c, sin_c)], axis=-1).astype(x.dtype)


def _to_heads(a, n_heads):
    b, s, _ = a.shape
    return a.reshape(b, s, n_heads, -1).transpose(0, 2, 1, 3).astype(jnp.float32)


def _seq_flip(a):
    return jnp.flip(a, axis=2)


def _block_attention(q, k, v):
    b, s, h, d = q.shape
    nb = s // Q_BLOCK
    scale = d ** -0.5
    qb = q.reshape(b, nb, Q_BLOCK, h, d).transpose(1, 0, 2, 3, 4)

    def one_block(qblk):
        logits = jnp.einsum('bqhd,bkhd->bhqk', qblk, k).astype(jnp.float32) * scale
        p = jax.nn.softmax(logits, axis=-1).astype(v.dtype)
        return jnp.einsum('bhqk,bkhd->bqhd', p, v)

    o = lax.map(one_block, qb)
    return o.transpose(1, 0, 2, 3, 4).reshape(b, s, h, v.shape[-1])


def _ret_update(r, k, v, lg):
    n = k.shape[2]
    pos = jnp.arange(n, dtype=jnp.float32)
    wk = jnp.exp(lg[:, None] * (n - 1 - pos))
    return r * jnp.exp(lg * n)[None, :, None, None] + jnp.einsum('bhjd,hj,bhjv->bhdv', k, wk, v)


def _ret_scan(q, k, v, lg, r0):
    b, h, s, _ = q.shape
    nc = s // RET_CHUNK

    def chunks(a):
        return jnp.moveaxis(a.reshape((b, h, nc, RET_CHUNK) + a.shape[3:]), 2, 0)

    pos = jnp.arange(RET_CHUNK, dtype=jnp.float32)
    rel = pos[:, None] - pos[None, :]
    d_intra = jnp.where(rel >= 0, jnp.exp(lg[:, None, None] * jnp.maximum(rel, 0.0)), 0.0)
    d_q = jnp.exp(lg[:, None] * (pos + 1.0))

    def step(r, inp):
        qc, kc, vc = inp
        sc = jnp.einsum('bhid,bhjd->bhij', qc, kc) * d_intra
        o = jnp.einsum('bhij,bhjv->bhiv', sc, vc) + jnp.einsum('bhid,hi,bhdv->bhiv', qc, d_q, r)
        return _ret_update(r, kc, vc, lg), o

    r_fin, o = lax.scan(step, r0, (chunks(q), chunks(k), chunks(v)))
    return jnp.moveaxis(o, 0, 2).reshape(b, h, s, -1), r_fin


def _mlstm_update(state, k, v, li, lf):
    c_mat, n_vec, m = state
    b_cum = jnp.cumsum(lf, axis=-1)
    b_end = b_cum[..., -1]
    lw = b_end[..., None] - b_cum + li
    m_new = jnp.maximum(b_end + m, jnp.max(lw, axis=-1))
    w = jnp.exp(lw - m_new[..., None])
    carry = jnp.exp(b_end + m - m_new)
    c_new = carry[..., None, None] * c_mat + jnp.einsum('bhs,bhsd,bhsv->bhdv', w, k, v)
    n_new = carry[..., None] * n_vec + jnp.einsum('bhs,bhsd->bhd', w, k)
    return (c_new, n_new, m_new)


def _mlstm_scan(q, k, v, li, lf, state0):
    b, h, s, _ = q.shape
    nc = s // M_CHUNK

    def chunks(a):
        return jnp.moveaxis(a.reshape((b, h, nc, M_CHUNK) + a.shape[3:]), 2, 0)

    tril = jnp.tril(jnp.ones((M_CHUNK, M_CHUNK), dtype=bool))

    def step(state, inp):
        c_mat, n_vec, m = state
        qc, kc, vc, ic, fc = inp
        b_cum = jnp.cumsum(fc, axis=-1)
        logd = jnp.where(tril, b_cum[..., :, None] - b_cum[..., None, :] + ic[..., None, :], NEG)
        inter = b_cum + m[..., None]
        m_t = jnp.maximum(inter, jnp.max(logd, axis=-1))
        sc = jnp.einsum('bhtd,bhsd->bhts', qc, kc) * jnp.exp(logd - m_t[..., None])
        w_inter = jnp.exp(inter - m_t)
        num = jnp.einsum('bhts,bhsv->bhtv', sc, vc) + w_inter[..., None] * jnp.einsum('bhtd,bhdv->bhtv', qc, c_mat)
        den = jnp.sum(sc, axis=-1) + w_inter * jnp.einsum('bhtd,bhd->bht', qc, n_vec)
        h_t = num / jnp.maximum(jnp.abs(den), jnp.exp(-m_t))[..., None]
        return _mlstm_update(state, kc, vc, ic, fc), h_t

    st, hs = lax.scan(step, state0, (chunks(q), chunks(k), chunks(v), chunks(li), chunks(lf)))
    return jnp.moveaxis(hs, 0, 2).reshape(b, h, s, -1), st


def _centred_conv(x, w, bias):
    ch = x.shape[-1]
    y = lax.conv_general_dilated(x, w[:, None, :], window_strides=(1,), padding='SAME',
                                 dimension_numbers=('NWC', 'WIO', 'NWC'), feature_group_count=ch)
    return y + bias


def _ab_project(h, w_in, q_norm, w_uq, kv_norm, w_ukv, tabs_mla, tabs_ret):
    b, s, _ = h.shape
    o1 = MLA_Q_LORA
    o2 = o1 + MLA_KV_LORA
    o3 = o2 + MLA_ROPE
    o4 = o3 + H_RET * RET_DK
    o5 = o4 + H_RET * RET_DK
    o6 = o5 + H_RET * RET_DV
    cq, ckv, kr, rq, rk, rv, rg = jnp.split(h @ w_in, [o1, o2, o3, o4, o5, o6], axis=-1)
    q = (_rms_norm(cq, q_norm) @ w_uq).reshape(b, s, H_MLA, MLA_NOPE + MLA_ROPE)
    kv = (_rms_norm(ckv, kv_norm) @ w_ukv).reshape(b, s, H_MLA, MLA_NOPE + MLA_V)
    q_nope, q_rope = jnp.split(q, [MLA_NOPE], axis=-1)
    k_nope, v = jnp.split(kv, [MLA_NOPE], axis=-1)
    k_rope = kr[:, :, None, :]
    rq = rq.reshape(b, s, H_RET, RET_DK)
    rk = rk.reshape(b, s, H_RET, RET_DK)
    if tabs_mla is not None:
        q_rope = _rope_2d(q_rope, tabs_mla)
        k_rope = _rope_2d(k_rope, tabs_mla)
        rq = _rope_2d(rq, tabs_ret)
        rk = _rope_2d(rk, tabs_ret)
    q = jnp.concatenate([q_nope, q_rope], axis=-1)
    k = jnp.concatenate([k_nope, jnp.broadcast_to(k_rope, (b, s, H_MLA, MLA_ROPE))], axis=-1)
    rq = rq.transpose(0, 2, 1, 3).astype(jnp.float32)
    rk = rk.transpose(0, 2, 1, 3).astype(jnp.float32) * RET_DK ** -0.5
    rv = _to_heads(rv, H_RET)
    return (q, k, v), (rq, rk, rv), rg


def _ab_merge(att, ret, rg, w_out):
    b, s = att.shape[:2]
    ret = _head_norm(ret.transpose(0, 2, 1, 3)).reshape(b, s, -1)
    ret = (jax.nn.silu(rg.astype(jnp.float32)) * ret).astype(rg.dtype)
    return jnp.concatenate([att.reshape(b, s, -1), ret], axis=-1) @ w_out


def _attn_ret_mixer(h_lat, h_ctx, w_in, q_norm, w_uq, kv_norm, w_ukv, log_decay, w_out,
                    tabs_mla, tabs_ret, need_ctx_out):
    (ql, kl, vl), (rql, rkl, rvl), rgl = _ab_project(h_lat, w_in, q_norm, w_uq, kv_norm, w_ukv, tabs_mla, tabs_ret)
    (qc, kc, vc), (rqc, rkc, rvc), rgc = _ab_project(h_ctx, w_in, q_norm, w_uq, kv_norm, w_ukv, None, None)
    lg_f = log_decay[0].astype(jnp.float32)
    lg_b = log_decay[1].astype(jnp.float32)
    r0 = jnp.zeros((h_lat.shape[0], H_RET, RET_DK, RET_DV), jnp.float32)
    fl = _seq_flip
    if need_ctx_out:
        ret_cf, r_f = _ret_scan(rqc, rkc, rvc, lg_f, r0)
        ret_cb, r_b = _ret_scan(fl(rqc), fl(rkc), fl(rvc), lg_b, r0)
        att_c = _block_attention(qc, kc, vc)
        y_ctx = _ab_merge(att_c, ret_cf + fl(ret_cb), rgc, w_out)
    else:
        r_f = _ret_update(r0, rkc, rvc, lg_f)
        r_b = _ret_update(r0, fl(rkc), fl(rvc), lg_b)
        y_ctx = None
    att_l = _block_attention(ql, jnp.concatenate([kl, kc], axis=1), jnp.concatenate([vl, vc], axis=1))
    ret_lf, _ = _ret_scan(rql, rkl, rvl, lg_f, r_f)
    ret_lb, _ = _ret_scan(fl(rql), fl(rkl), fl(rvl), lg_b, r_b)
    y_lat = _ab_merge(att_l, ret_lf + fl(ret_lb), rgl, w_out)
    return y_lat, y_ctx


def _mlstm_project(h, w_in, conv_w, conv_b, gate_b):
    b, s, _ = h.shape
    o1 = 2 * H_M * M_DK
    o2 = o1 + H_M * M_DV
    o3 = o2 + H_M * M_DV
    qk, v, og, g = jnp.split(h @ w_in, [o1, o2, o3], axis=-1)
    qk = jax.nn.silu(_centred_conv(qk, conv_w, conv_b))
    q, k = jnp.split(qk, 2, axis=-1)
    q = _to_heads(q, H_M)
    k = _to_heads(k, H_M) * M_DK ** -0.5
    v = _to_heads(v, H_M)
    g = (g.reshape(b, s, 4, H_M) + gate_b).astype(jnp.float32).transpose(2, 0, 3, 1)
    fwd = (g[0], jax.nn.log_sigmoid(g[1]))
    bwd = (g[2], jax.nn.log_sigmoid(g[3]))
    return q, k, v, og, fwd, bwd


def _mlstm_merge(h_sum, og, norm_g, w_out):
    b, s = og.shape[:2]
    hn = _head_norm(h_sum.transpose(0, 2, 1, 3)).reshape(b, s, -1) * norm_g
    return (jax.nn.sigmoid(og.astype(jnp.float32)) * hn).astype(og.dtype) @ w_out


def _mlstm_mixer(h_lat, h_ctx, w_in, conv_w, conv_b, gate_b, norm_g, w_out, need_ctx_out):
    ql, kl, vl, ogl, gfl, gbl = _mlstm_project(h_lat, w_in, conv_w, conv_b, gate_b)
    qc, kc, vc, ogc, gfc, gbc = _mlstm_project(h_ctx, w_in, conv_w, conv_b, gate_b)
    b = h_lat.shape[0]
    zero = (jnp.zeros((b, H_M, M_DK, M_DV), jnp.float32), jnp.zeros((b, H_M, M_DK), jnp.float32),
            jnp.zeros((b, H_M), jnp.float32))
    fl = _seq_flip
    if need_ctx_out:
        hcf, st_f = _mlstm_scan(qc, kc, vc, gfc[0], gfc[1], zero)
        hcb, st_b = _mlstm_scan(fl(qc), fl(kc), fl(vc), fl(gbc[0]), fl(gbc[1]), zero)
        y_ctx = _mlstm_merge(hcf + fl(hcb), ogc, norm_g, w_out)
    else:
        st_f = _mlstm_update(zero, kc, vc, gfc[0], gfc[1])
        st_b = _mlstm_update(zero, fl(kc), fl(vc), fl(gbc[0]), fl(gbc[1]))
        y_ctx = None
    hlf, _ = _mlstm_scan(ql, kl, vl, gfl[0], gfl[1], st_f)
    hlb, _ = _mlstm_scan(fl(ql), fl(kl), fl(vl), fl(gbl[0]), fl(gbl[1]), st_b)
    y_lat = _mlstm_merge(hlf + fl(hlb), ogl, norm_g, w_out)
    return y_lat, y_ctx


def setup_inputs(seed: int = 0) -> dict:
    key = jax.random.key(seed)
    ks = jax.random.split(key, 24)
    f32 = jnp.float32
    D = D_MODEL

    def nrm(k, shape, s):
        return s * jax.random.normal(k, shape, f32)

    ret_base = jnp.log1p(-(2.0 ** (-5.0 - jnp.arange(H_RET, dtype=f32))))
    f_lin = jnp.linspace(3.0, 6.0, H_M, dtype=f32)
    zeros_h = jnp.zeros((H_M,), f32)
    gate_base = jnp.stack([zeros_h, f_lin, zeros_h, f_lin])
    return {
        'x': nrm(ks[0], (BATCH, SEQ, D), 1.0),
        'c': nrm(ks[1], (BATCH, D), 1.0),
        'ctx': nrm(ks[2], (BATCH, CTX_LEN, D), 1.0),
        'c_ctx': nrm(ks[3], (D,), 1.0),
        'mod_w': nrm(ks[4], (DEPTH, D, 6 * D), 0.5 * D ** -0.5),
        'mod_b': nrm(ks[5], (DEPTH, 6 * D), 0.02),
        'ln_g': 1.0 + nrm(ks[6], (DEPTH, 2, D), 0.02),
        'ln_b': nrm(ks[7], (DEPTH, 2, D), 0.02),
        'ffn_w_in': nrm(ks[8], (DEPTH, D, 2 * D_FF), D ** -0.5),
        'ffn_w_out': nrm(ks[9], (DEPTH, D_FF, D), BETA * D_FF ** -0.5),
        'ab_w_in': nrm(ks[10], (N_EVEN, D, AB_IN), D ** -0.5),
        'mla_q_norm': 1.0 + nrm(ks[11], (N_EVEN, MLA_Q_LORA), 0.02),
        'mla_w_uq': nrm(ks[12], (N_EVEN, MLA_Q_LORA, H_MLA * (MLA_NOPE + MLA_ROPE)), MLA_Q_LORA ** -0.5),
        'mla_kv_norm': 1.0 + nrm(ks[13], (N_EVEN, MLA_KV_LORA), 0.02),
        'mla_w_ukv': nrm(ks[14], (N_EVEN, MLA_KV_LORA, H_MLA * (MLA_NOPE + MLA_V)), MLA_KV_LORA ** -0.5),
        'ret_log_decay': ret_base * (1.0 + nrm(ks[15], (N_EVEN, 2, H_RET), 0.05)),
        'ab_w_out': nrm(ks[16], (N_EVEN, AB_MIX, D), BETA * AB_MIX ** -0.5),
        'm_w_in': nrm(ks[17], (N_ODD, D, M_IN), D ** -0.5),
        'm_conv_w': nrm(ks[18], (N_ODD, CONV_W, 2 * H_M * M_DK), CONV_W ** -0.5),
        'm_conv_b': nrm(ks[19], (N_ODD, 2 * H_M * M_DK), 0.02),
        'm_gate_b': gate_base[None] + nrm(ks[20], (N_ODD, 4, H_M), 0.1),
        'm_norm_g': 1.0 + nrm(ks[21], (N_ODD, M_MIX), 0.02),
        'm_w_out': nrm(ks[22], (N_ODD, M_MIX, D), BETA * M_MIX ** -0.5),
    }


def reference(x, c, ctx, c_ctx, mod_w, mod_b, ln_g, ln_b, ffn_w_in, ffn_w_out,
              ab_w_in, mla_q_norm, mla_w_uq, mla_kv_norm, mla_w_ukv, ret_log_decay, ab_w_out,
              m_w_in, m_conv_w, m_conv_b, m_gate_b, m_norm_g, m_w_out):
    n_lat = x.shape[1]
    tabs_mla = _axial_tables(n_lat, MLA_ROPE)
    tabs_ret = _axial_tables(n_lat, RET_DK)
    sc = jax.nn.silu(c)
    sc_ctx = jax.nn.silu(c_ctx)
    for l in range(DEPTH):
        last = l == DEPTH - 1
        ml = [m[:, None, :] for m in jnp.split(sc @ mod_w[l] + mod_b[l], 6, axis=-1)]
        mc = jnp.split(sc_ctx @ mod_w[l] + mod_b[l], 6, axis=-1)
        h_lat = _modulate(x, ml[0], ml[1])
        h_ctx = _modulate(ctx, mc[0], mc[1])
        j = l // 2
        if l % 2 == 0:
            y_lat, y_ctx = _attn_ret_mixer(h_lat, h_ctx, ab_w_in[j], mla_q_norm[j], mla_w_uq[j], mla_kv_norm[j],
                                           mla_w_ukv[j], ret_log_decay[j], ab_w_out[j], tabs_mla, tabs_ret,
                                           not last)
        else:
            y_lat, y_ctx = _mlstm_mixer(h_lat, h_ctx, m_w_in[j], m_conv_w[j], m_conv_b[j], m_gate_b[j],
                                        m_norm_g[j], m_w_out[j], not last)
        x = _layer_norm(ALPHA * x + ml[2] * y_lat, ln_g[l, 0], ln_b[l, 0])
        x = _layer_norm(ALPHA * x + ml[5] * _swiglu(_modulate(x, ml[3], ml[4]), ffn_w_in[l], ffn_w_out[l]),
                        ln_g[l, 1], ln_b[l, 1])
        if not last:
            ctx = _layer_norm(ALPHA * ctx + mc[2] * y_ctx, ln_g[l, 0], ln_b[l, 0])
            ctx = _layer_norm(ALPHA * ctx + mc[5] * _swiglu(_modulate(ctx, mc[3], mc[4]), ffn_w_in[l], ffn_w_out[l]),
                              ln_g[l, 1], ln_b[l, 1])
    return x
```

```cpp
#include <hip/hip_runtime.h>
#include <hip/hip_cooperative_groups.h>
#include <cstdio>
#include <cstdint>
namespace cg = cooperative_groups;

#ifndef MULTI_LAUNCH
#define MULTI_LAUNCH 0
#endif

#define DI __device__ __forceinline__
typedef unsigned short bf16_t;
typedef __bf16 bf16v2 __attribute__((ext_vector_type(2)));
typedef float f32x2 __attribute__((ext_vector_type(2)));
typedef short s16x8 __attribute__((ext_vector_type(8)));
typedef short s16x4 __attribute__((ext_vector_type(4)));
typedef float f32x16 __attribute__((ext_vector_type(16)));
typedef float f32x4 __attribute__((ext_vector_type(4)));
typedef unsigned u32x4 __attribute__((ext_vector_type(4)));
typedef unsigned u32x2 __attribute__((ext_vector_type(2)));

constexpr int DM = 1024, NB = 4, SEQ = 8192, CTXL = 256, TT = SEQ + CTXL  , RT = NB * TT  ;
constexpr int DFF = 2816;
constexpr float EPS = 1e-5f;
constexpr float ALPHA = 1.41421356237309515f;
constexpr int NTHR = 256;
constexpr int LDS_BYTES = 77824;

constexpr size_t al256(size_t x) { return (x + 255) & ~(size_t)255; }
constexpr size_t W_ABIN = 0;
constexpr size_t W_UQ = W_ABIN + al256((size_t)2816 * 1024 * 2);
constexpr size_t W_UKV = W_UQ + al256((size_t)768 * 384 * 2);
constexpr size_t W_ABOUT = W_UKV + al256((size_t)1024 * 256 * 2);
constexpr size_t W_FFIN = W_ABOUT + al256((size_t)1024 * 1024 * 2);
constexpr size_t W_FFOUT = W_FFIN + al256((size_t)2 * 5632 * 1024 * 2);
constexpr size_t W_MIN = W_FFOUT + al256((size_t)2 * 1024 * 2816 * 2);
constexpr size_t W_MOUT = W_MIN + al256((size_t)3200 * 1024 * 2);
constexpr size_t O_MODV = W_MOUT + al256((size_t)1024 * 1024 * 2);
constexpr size_t O_TABR = O_MODV + al256((size_t)2 * 5 * 6144 * 4);
constexpr size_t O_TABM = O_TABR + al256((size_t)128 * 32 * 2 * 4);
constexpr size_t O_XCTX = O_TABM + al256((size_t)128 * 8 * 2 * 4);
constexpr size_t O_SSQ = O_XCTX + al256((size_t)1024 * 1024 * 4);
constexpr size_t O_STATS = O_SSQ + al256((size_t)RT * 8 * 4);
constexpr size_t O_H = O_STATS + al256((size_t)3 * RT * 8 * 4);
constexpr size_t O_BAR = O_H + al256((size_t)RT * 1024 * 2);
constexpr size_t O_ARENA = O_BAR + al256((size_t)16384);
constexpr size_t A0_RQ = O_ARENA;
constexpr size_t A0_RK = A0_RQ + al256((size_t)RT * 512 * 2);
constexpr size_t A0_RVT = A0_RK + al256((size_t)RT * 512 * 2);
constexpr size_t A0_RG = A0_RVT + al256((size_t)RT * 512 * 2);
constexpr size_t A0_QB = A0_RG + al256((size_t)RT * 512 * 2);
constexpr size_t A0_KB = A0_QB + al256((size_t)NB * 8 * TT * 96 * 2);
constexpr size_t A0_VT = A0_KB + al256((size_t)NB * 8 * TT * 96 * 2);
constexpr size_t A0_RUS = A0_VT + al256((size_t)NB * 8 * 64 * TT * 2);
constexpr size_t A0_CQ = A0_RUS + al256((size_t)NB * 4 * 2 * 66 * 128 * 128 * 2);
constexpr size_t A0_CKV = A0_CQ + al256((size_t)RT * 384 * 2);
constexpr size_t A0_END = A0_CKV + al256((size_t)RT * 256 * 2);
constexpr size_t O_PART = O_ARENA + (size_t)200 * 1024 * 1024;
constexpr size_t O_ACT = O_ARENA;
constexpr size_t A1_QKPRE = O_ARENA;
constexpr size_t A1_VT = A1_QKPRE + al256((size_t)RT * 1024 * 2);
constexpr size_t A1_OG = A1_VT + al256((size_t)RT * 1024 * 2);
constexpr size_t A1_G = A1_OG + al256((size_t)RT * 1024 * 2);
constexpr size_t A1_U = A1_G + al256((size_t)RT * 32 * 4);
constexpr size_t A1_N = A1_U + al256((size_t)NB * 8 * 2 * 132 * 128 * 64 * 2);
constexpr size_t A1_SC = A1_N + al256((size_t)NB * 8 * 2 * 132 * 64 * 4);
constexpr size_t A1_HALO = A1_SC + al256((size_t)NB * 8 * 2 * 132 * 4 * 4);
constexpr size_t A1_END = A1_HALO + al256((size_t)(RT / 128) * 4 * 1024 * 4);
constexpr size_t WS_NEED = (A0_END > A1_END ? A0_END : A1_END);
static_assert(WS_NEED <= (size_t)536870912, "workspace over 512 MiB");
static_assert(O_ACT + (size_t)RT * 2816 * 2 <= WS_NEED, "act");

struct Params {
    const float *x, *c, *ctx, *c_ctx, *mod_w, *mod_b, *ln_g, *ln_b, *ffn_w_in, *ffn_w_out, *ab_w_in, *q_norm, *w_uq, *kv_norm, *w_ukv,
        *ret_ld, *ab_w_out, *m_w_in, *m_conv_w, *m_conv_b, *m_gate_b, *m_norm_g, *m_w_out;
    float* out; char* ws; int ph_lo, ph_hi;
};

DI unsigned pk(float lo, float hi) { f32x2 v = {lo, hi}; return __builtin_bit_cast(unsigned, __builtin_convertvector(v, bf16v2)); }
DI float bflo(unsigned u) { return __uint_as_float(u << 16); }
DI float bfhi(unsigned u) { return __uint_as_float(u & 0xffff0000u); }
DI bf16_t f2bf(float x) { return (bf16_t)(pk(x, 0.f) & 0xffffu); }
DI float bf2f(bf16_t x) { return __uint_as_float(((unsigned)x) << 16); }
DI int crow(int reg, int h2) { return (reg & 3) + 8 * (reg >> 2) + 4 * h2; }
DI float siluf(float x) { return x * __builtin_amdgcn_rcpf(1.f + __expf(-x)); }
DI float sigmf(float x) { return __builtin_amdgcn_rcpf(1.f + __expf(-x)); }
#define MFMA32(a, b, c) __builtin_amdgcn_mfma_f32_32x32x16_bf16((a), (b), (c), 0, 0, 0)
DI s16x8 pack8(float a0, float a1, float a2, float a3, float a4, float a5, float a6, float a7) {
    u32x4 t = {pk(a0, a1), pk(a2, a3), pk(a4, a5), pk(a6, a7)}; return __builtin_bit_cast(s16x8, t);
}
DI s16x8 cat4(s16x4 lo, s16x4 hi) { return __builtin_shufflevector(lo, hi, 0, 1, 2, 3, 4, 5, 6, 7); }
DI void zero16(f32x16& v) {
#pragma unroll
    for (int i = 0; i < 16; ++i) v[i] = 0.f;
}
DI float* xrow(const Params& p, int g) {
    const int b = g / TT, t = g - b * TT;
    return t < CTXL ? (float*)(p.ws + O_XCTX) + (size_t)(b * CTXL + t) * DM : p.out + (size_t)(b * SEQ + t - CTXL) * DM;
}
DI const float* xrow_in(const Params& p, int g) {
    const int b = g / TT, t = g - b * TT;
    return t < CTXL ? p.ctx + (size_t)(b * CTXL + t) * DM : p.x + (size_t)(b * SEQ + t - CTXL) * DM;
}
DI int modidx(int g) { const int b = g / TT, t = g - b * TT; return t < CTXL ? 4 : b; }

template <class Map>
DI void wconv(const float* src, int K, int Nsrc, int Ndst, bf16_t* dst, const float* rowscale, Map map, int gtid, int gthreads) {
    const int k8n = K >> 3; const long items = (long)Ndst * k8n;
    for (long it = gtid; it < items; it += gthreads) {
        const int n = (int)(it % Ndst), k8 = (int)(it / Ndst);
        const int sn = map(n);
        float v[8];
#pragma unroll
        for (int j = 0; j < 8; ++j) {
            const int k = k8 * 8 + j;
            float x = sn >= 0 ? src[(size_t)k * Nsrc + sn] : 0.f;
            if (rowscale) x *= rowscale[k];
            v[j] = x;
        }
        u32x4 o = {pk(v[0], v[1]), pk(v[2], v[3]), pk(v[4], v[5]), pk(v[6], v[7])};
        *(u32x4*)(dst + (size_t)n * K + k8 * 8) = o;
    }
}
struct MapId { int nsrc; DI int operator()(int n) const { return n < nsrc ? n : -1; } };
struct MapAbIn { DI int operator()(int n) const { return n < 640 ? n : (n < 2688 ? n + 32 : (n < 2720 ? n - 2688 + 640 : -1)); } };
struct MapUq { DI int operator()(int n) const { if (n < 512) return (n >> 6) * 96 + (n & 63); const int m = n - 512; return (m >> 5) * 96 + 64 + (m & 31); } };
struct MapFfIn { DI int operator()(int n) const { const int t = n >> 7, j = n & 127; return j < 64 ? t * 64 + j : 2816 + t * 64 + (j - 64); } };

DI void sincos_acc(float theta, float& c, float& s) {
    const double th = (double)theta;
    const double kq = __builtin_rint(th * 0.63661977236758134308);
    const double r = (th - kq * 1.57079632679489655800) - kq * 6.123233995736766e-17;
    const double r2 = r * r;
    const double sp = r * (1.0 + r2 * (-1.0 / 6 + r2 * (1.0 / 120 + r2 * (-1.0 / 5040 + r2 * (1.0 / 362880 + r2 * (-1.0 / 39916800 + r2 * (1.0 / 6227020800.0)))))));
    const double cp = 1.0 + r2 * (-0.5 + r2 * (1.0 / 24 + r2 * (-1.0 / 720 + r2 * (1.0 / 40320 + r2 * (-1.0 / 3628800 + r2 * (1.0 / 479001600.0 + r2 * (-1.0 / 87178291200.0)))))));
    const int q = ((int)kq) & 3;
    const double cc = (q == 0) ? cp : (q == 1) ? -sp : (q == 2) ? -cp : sp;
    const double ss = (q == 0) ? sp : (q == 1) ? cp : (q == 2) ? -sp : -cp;
    c = (float)cc; s = (float)ss;
}

DI void phase_prologue(const Params& p, char* lds, int bid, int nb) {
    const int tid = threadIdx.x; const int gtid = bid * NTHR + tid, gthreads = nb * NTHR;
    char* ws = p.ws;
    wconv(p.ab_w_in, 1024, 2720, 2816, (bf16_t*)(ws + W_ABIN), nullptr, MapAbIn{}, gtid, gthreads);
    wconv(p.w_uq, 384, 768, 768, (bf16_t*)(ws + W_UQ), p.q_norm, MapUq{}, gtid, gthreads);
    wconv(p.w_ukv, 256, 1024, 1024, (bf16_t*)(ws + W_UKV), p.kv_norm, MapId{1024}, gtid, gthreads);
    wconv(p.ab_w_out, 1024, 1024, 1024, (bf16_t*)(ws + W_ABOUT), nullptr, MapId{1024}, gtid, gthreads);
    for (int l = 0; l < 2; ++l) {
        wconv(p.ffn_w_in + (size_t)l * 1024 * 5632, 1024, 5632, 5632, (bf16_t*)(ws + W_FFIN) + (size_t)l * 5632 * 1024, nullptr, MapFfIn{}, gtid, gthreads);
        wconv(p.ffn_w_out + (size_t)l * 2816 * 1024, 2816, 1024, 1024, (bf16_t*)(ws + W_FFOUT) + (size_t)l * 1024 * 2816, nullptr, MapId{1024}, gtid, gthreads);
    }
    wconv(p.m_w_in, 1024, 3104, 3200, (bf16_t*)(ws + W_MIN), nullptr, MapId{3104}, gtid, gthreads);
    wconv(p.m_w_out, 1024, 1024, 1024, (bf16_t*)(ws + W_MOUT), nullptr, MapId{1024}, gtid, gthreads);
    if (gtid < 128 * 32) {
        const int pos = gtid >> 5, i = gtid & 31;
        const float inv = exp2f(-(float)i * (13.28771237954945f / 32.f));
        float c, s; sincos_acc((float)pos * inv, c, s);
        float* t = (float*)(ws + O_TABR) + (size_t)gtid * 2; t[0] = c; t[1] = s;
    } else if (gtid < 128 * 32 + 128 * 8) {
        const int j = gtid - 128 * 32; const int pos = j >> 3, i = j & 7;
        const float inv = exp2f(-(float)i * (13.28771237954945f / 8.f));
        float c, s; sincos_acc((float)pos * inv, c, s);
        float* t = (float*)(ws + O_TABM) + (size_t)j * 2; t[0] = c; t[1] = s;
    }
    float* sc = (float*)lds;
    float* red = sc + 5 * 1024;
    bool have = false;
    for (int u = bid; u < 2 * 96; u += nb) {
        if (!have) {
            for (int i = tid; i < 5 * 1024; i += NTHR) { const float v = i < 4096 ? p.c[i] : p.c_ctx[i - 4096]; sc[i] = siluf(v); }
            __syncthreads(); have = true;
        }
        const int l = u / 96, nblk = u - l * 96; const int col = nblk * 64 + (tid & 63), kq = tid >> 6;
        const float* w = p.mod_w + (size_t)l * 1024 * 6144 + col;
        float a[5] = {0.f, 0.f, 0.f, 0.f, 0.f};
        for (int k = kq * 256; k < kq * 256 + 256; ++k) {
            const float wv = w[(size_t)k * 6144];
#pragma unroll
            for (int m = 0; m < 5; ++m) a[m] += sc[m * 1024 + k] * wv;
        }
#pragma unroll
        for (int m = 0; m < 5; ++m) red[(kq * 5 + m) * 64 + (tid & 63)] = a[m];
        __syncthreads();
        if (tid < 64) {
            const float bias = p.mod_b[l * 6144 + col];
#pragma unroll
            for (int m = 0; m < 5; ++m) {
                const float s = red[(0 * 5 + m) * 64 + tid] + red[(1 * 5 + m) * 64 + tid] + red[(2 * 5 + m) * 64 + tid] + red[(3 * 5 + m) * 64 + tid];
                ((float*)(ws + O_MODV))[(size_t)(l * 5 + m) * 6144 + col] = s + bias;
            }
        }
        __syncthreads();
    }
}

DI void phase_modulate0(const Params& p, int bid, int nb) {
    const int tid = threadIdx.x; const long gtid = (long)bid * NTHR + tid, gthreads = (long)nb * NTHR;
    const float* modv = (const float*)(p.ws + O_MODV);
    bf16_t* H = (bf16_t*)(p.ws + O_H);
    for (long it = gtid; it < (long)RT * 128; it += gthreads) {
        const int g = (int)(it >> 7), c8 = (int)(it & 127) * 8;
        const float* xr = xrow_in(p, g) + c8; const int mi = modidx(g);
        const float* sh = modv + (size_t)(0 * 5 + mi) * 6144 + 0 * 1024 + c8; const float* sc = sh + 1024;
        const f32x4 a = *(const f32x4*)xr, b = *(const f32x4*)(xr + 4);
        const f32x4 s0 = *(const f32x4*)sh, s1 = *(const f32x4*)(sh + 4), c0 = *(const f32x4*)sc, c1 = *(const f32x4*)(sc + 4);
        const f32x4 y0 = a * (1.f + c0) + s0, y1 = b * (1.f + c1) + s1;
        u32x4 o = {pk(y0[0], y0[1]), pk(y0[2], y0[3]), pk(y1[0], y1[1]), pk(y1[2], y1[3])};
        *(u32x4*)(H + (size_t)g * 1024 + c8) = o;
    }
}

struct GemmArgs { const bf16_t* A; int lda; const bf16_t* Bt; int ldb; int K; int ntm; int ntn; int latonly; int ksplit; };
constexpr int GST = 72;
constexpr int CST = 136;
constexpr int EPI_AUX = 69632;

template <class Epi>
DI void gemm_phase(const GemmArgs& ga, const Epi& epi, char* lds, int bid, int nb) {
    constexpr int KS = 40;
    bf16_t* As = (bf16_t*)lds;
    bf16_t* Bs = As + 2 * 256 * KS;
    float* Cs = (float*)lds;
    const int tid = threadIdx.x, lane = tid & 63, w = tid >> 6, wm = w >> 1, wn = w & 1, l31 = lane & 31, h2 = lane >> 5;
    const int ks_ = ga.ksplit > 1 ? ga.ksplit : 1; const int klen = ga.K / ks_;
    const int ntnv = ga.ntn * ks_;
    const int ntiles = ga.ntm * ntnv, nk = klen >> 5;
    const int xcd = bid & 7, jx = bid >> 3, per = nb >> 3;
    const int nchunk = (ntiles + 63) >> 6;
    const int spc = (64 + per - 1) / per;
    const int lr = tid >> 2, lc = (tid & 3) * 8;
    for (int it = 0;; ++it) {
        const int q = xcd + 8 * (it / spc), tslot = jx + per * (it % spc);
        if (q >= nchunk) break;
        const int tile = q * 64 + tslot;
        if (tslot >= 64 || tile >= ntiles) continue;
        const int grp = tile / (4 * ntnv), rem = tile - grp * 4 * ntnv;
        const int ntv = rem >> 2, mt = grp * 4 + (rem & 3);
        const int part = ntv / ga.ntn, nt = ntv - part * ga.ntn;
        const int g0 = ga.latonly == 1 ? ((mt >> 5) * TT + CTXL + (mt & 31) * 256) : (ga.latonly == 2 ? mt * TT : mt * 256);
        const bf16_t* Ag = ga.A + (size_t)(g0 + lr) * ga.lda + lc + part * klen;
        const bf16_t* Bg = ga.Bt + (size_t)(nt * 128 + lr) * ga.ldb + lc + part * klen;
        const size_t a64 = (size_t)64 * ga.lda, b64 = (size_t)64 * ga.ldb;
        f32x16 acc[4][2];
#pragma unroll
        for (int i = 0; i < 4; ++i)
#pragma unroll
            for (int j = 0; j < 2; ++j) zero16(acc[i][j]);
        u32x4 ra0[4], rb0[2], ra1[4], rb1[2];
#define G_LOAD(RA, RB, K0) { _Pragma("unroll") for (int i = 0; i < 4; ++i) RA[i] = *(const u32x4*)(Ag + i * a64 + (K0)); \
                             _Pragma("unroll") for (int i = 0; i < 2; ++i) RB[i] = *(const u32x4*)(Bg + i * b64 + (K0)); }
#define G_STORE(RA, RB, ST) { bf16_t* Aw = As + (ST) * 256 * KS; bf16_t* Bw = Bs + (ST) * 128 * KS; \
                             _Pragma("unroll") for (int i = 0; i < 4; ++i) *(u32x4*)(Aw + (lr + 64 * i) * KS + lc) = RA[i]; \
                             _Pragma("unroll") for (int i = 0; i < 2; ++i) *(u32x4*)(Bw + (lr + 64 * i) * KS + lc) = RB[i]; }
#define G_COMPUTE_STORE(ST, RA, RB, LA, LB, LK) { const bf16_t* Ac = As + (ST) * 256 * KS + (wm * 128 + l31) * KS + h2 * 8; \
                        const bf16_t* Bc = Bs + (ST) * 128 * KS + (wn * 64 + l31) * KS + h2 * 8; \
                        s16x8 fa0[4], fb0[2], fa1[4], fb1[2]; \
                        _Pragma("unroll") for (int mi = 0; mi < 4; ++mi) fa0[mi] = *(const s16x8*)(Ac + mi * 32 * KS); \
                        fb0[0] = *(const s16x8*)(Bc); fb0[1] = *(const s16x8*)(Bc + 32 * KS); \
                        G_LOAD(LA, LB, LK) \
                        _Pragma("unroll") for (int mi = 0; mi < 4; ++mi) fa1[mi] = *(const s16x8*)(Ac + mi * 32 * KS + 16); \
                        fb1[0] = *(const s16x8*)(Bc + 16); fb1[1] = *(const s16x8*)(Bc + 32 * KS + 16); \
                        _Pragma("unroll") for (int mi = 0; mi < 4; ++mi) { acc[mi][0] = MFMA32(fa0[mi], fb0[0], acc[mi][0]); acc[mi][1] = MFMA32(fa0[mi], fb0[1], acc[mi][1]); } \
                        _Pragma("unroll") for (int mi = 0; mi < 4; ++mi) { acc[mi][0] = MFMA32(fa1[mi], fb1[0], acc[mi][0]); acc[mi][1] = MFMA32(fa1[mi], fb1[1], acc[mi][1]); } \
                        G_STORE(RA, RB, (ST) ^ 1) \
                        __builtin_amdgcn_sched_group_barrier(0x100, 6, 0); \
                        __builtin_amdgcn_sched_group_barrier(0x008, 2, 0); __builtin_amdgcn_sched_group_barrier(0x100, 2, 0); __builtin_amdgcn_sched_group_barrier(0x020, 2, 0); \
                        __builtin_amdgcn_sched_group_barrier(0x008, 2, 0); __builtin_amdgcn_sched_group_barrier(0x100, 2, 0); __builtin_amdgcn_sched_group_barrier(0x020, 2, 0); \
                        __builtin_amdgcn_sched_group_barrier(0x008, 2, 0); __builtin_amdgcn_sched_group_barrier(0x100, 1, 0); __builtin_amdgcn_sched_group_barrier(0x020, 2, 0); \
                        __builtin_amdgcn_sched_group_barrier(0x008, 2, 0); __builtin_amdgcn_sched_group_barrier(0x100, 1, 0); \
                        __builtin_amdgcn_sched_group_barrier(0x008, 2, 0); __builtin_amdgcn_sched_group_barrier(0x200, 2, 0); \
                        __builtin_amdgcn_sched_group_barrier(0x008, 2, 0); __builtin_amdgcn_sched_group_barrier(0x200, 2, 0); \
                        __builtin_amdgcn_sched_group_barrier(0x008, 2, 0); __builtin_amdgcn_sched_group_barrier(0x200, 2, 0); \
                        __builtin_amdgcn_sched_group_barrier(0x008, 2, 0); \
                        __builtin_amdgcn_sched_barrier(0); }
        G_LOAD(ra0, rb0, 0)
        G_STORE(ra0, rb0, 0)
        G_LOAD(ra0, rb0, 32)
        __syncthreads();
        for (int kt = 0; kt < nk; kt += 2) {
            { const int kk = (kt + 2 < nk ? kt + 2 : nk - 1) * 32;
              G_COMPUTE_STORE(0, ra0, rb0, ra1, rb1, kk) }
            __syncthreads();
            { const int kk = (kt + 3 < nk ? kt + 3 : nk - 1) * 32;
              G_COMPUTE_STORE(1, ra1, rb1, ra0, rb0, kk) }
            __syncthreads();
        }
#undef G_LOAD
#undef G_STORE
#undef G_COMPUTE_STORE
#pragma unroll
        for (int hh = 0; hh < 2; ++hh) {
            if (wm == hh) {
#pragma unroll
                for (int mi = 0; mi < 4; ++mi)
#pragma unroll
                    for (int ni = 0; ni < 2; ++ni)
#pragma unroll
                        for (int r = 0; r < 16; ++r) Cs[(mi * 32 + crow(r, h2)) * CST + wn * 64 + ni * 32 + l31] = acc[mi][ni][r];
            }
            __syncthreads();
            epi(Cs, lds, g0 + hh * 128, nt + ga.ntn * part);
            __syncthreads();
        }
    }
}

template <int NCOLS>
DI void twrite(const float* Cs, int c_lo, bf16_t* dst, size_t ld, const float* rowscale) {
    constexpr int TPC = 256 / NCOLS, RPT = 128 / TPC;
    int tid = threadIdx.x; asm volatile("" : "+v"(tid)); const int c = tid % NCOLS, part = tid / NCOLS;
    const float* src = Cs + c_lo + c;
    bf16_t* d = dst + (size_t)c * ld + part * RPT;
#pragma unroll 2
    for (int j = 0; j < RPT / 8; ++j) {
        float v[8];
#pragma unroll
        for (int e = 0; e < 8; ++e) { const int row = part * RPT + j * 8 + e; float x = src[row * CST]; if (rowscale) x *= rowscale[row]; v[e] = x; }
        u32x4 o = {pk(v[0], v[1]), pk(v[2], v[3]), pk(v[4], v[5]), pk(v[6], v[7])};
        *(u32x4*)(d + j * 8) = o;
    }
}

DI f32x4 rope4(f32x4 v, f32x4 pv, const float* tab, bool second) {
    const f32x4 t0 = *(const f32x4*)tab, t1 = *(const f32x4*)(tab + 4);
    const f32x4 cs = {t0[0], t0[2], t1[0], t1[2]}, sn = {t0[1], t0[3], t1[1], t1[3]};
    return second ? pv * sn + v * cs : v * cs - pv * sn;
}

struct EpiAbIn {
    Params p;
    DI void operator()(const float* Cs, char* lds, int g0, int nt) const {
        int tid = threadIdx.x; asm volatile("" : "+v"(tid)); const int lane = tid & 63, w = tid >> 6, l31 = lane & 31, h2 = lane >> 5;
        const int b = g0 / TT, t0 = g0 - b * TT; const bool lat = t0 >= CTXL; const int c = 4 * l31;
        char* ws = p.ws;
        if (nt < 5) {
            bf16_t* dst = nt < 3 ? (bf16_t*)(ws + A0_CQ) + (size_t)g0 * 384 + nt * 128 : (bf16_t*)(ws + A0_CKV) + (size_t)g0 * 256 + (nt - 3) * 128;
            const int ld = nt < 3 ? 384 : 256;
            float* ssq = (float*)(ws + O_SSQ);
#pragma unroll 1
            for (int i = 0; i < 16; ++i) {
                const int row = w * 32 + 2 * i + h2;
                const f32x4 v = *(const f32x4*)(Cs + row * CST + c);
                float ss = v[0] * v[0] + v[1] * v[1] + v[2] * v[2] + v[3] * v[3];
                ss += __shfl_xor(ss, 1); ss += __shfl_xor(ss, 2); ss += __shfl_xor(ss, 4); ss += __shfl_xor(ss, 8); ss += __shfl_xor(ss, 16);
                u32x2 o = {pk(v[0], v[1]), pk(v[2], v[3])};
                *(u32x2*)(dst + (size_t)row * ld + c) = o;
                if (l31 == 0) ssq[(size_t)(g0 + row) * 8 + nt] = ss;
            }
        } else if (nt < 13) {
            const bool isk = nt >= 9; const int hh = (nt - 5) & 3;
            bf16_t* dst = (bf16_t*)(ws + (isk ? A0_RK : A0_RQ)) + (size_t)g0 * 512 + hh * 128;
            const float scl = isk ? 0.08838834764831845f : 1.f;
            const float* tab = (const float*)(ws + O_TABR);
#pragma unroll 1
            for (int i = 0; i < 16; ++i) {
                const int row = w * 32 + 2 * i + h2;
                f32x4 v = *(const f32x4*)(Cs + row * CST + c);
                if (lat) {
                    const f32x4 pv = *(const f32x4*)(Cs + row * CST + (c ^ 32));
                    const int s = t0 + row - CTXL; const int pos = c < 64 ? (s >> 6) : (s & 63);
                    v = rope4(v, pv, tab + (size_t)(pos * 32 + (c & 31)) * 2, (c & 32) != 0);
                }
                v = v * scl;
                u32x2 o = {pk(v[0], v[1]), pk(v[2], v[3])};
                *(u32x2*)(dst + (size_t)row * 512 + c) = o;
            }
        } else if (nt < 17) {
            const int hh = nt - 13;
            twrite<128>(Cs, 0, (bf16_t*)(ws + A0_RVT) + ((size_t)(b * 4 + hh) * 128) * TT + t0, TT, nullptr);
        } else if (nt < 21) {
            bf16_t* dst = (bf16_t*)(ws + A0_RG) + (size_t)g0 * 512 + (nt - 17) * 128;
#pragma unroll 1
            for (int i = 0; i < 16; ++i) {
                const int row = w * 32 + 2 * i + h2;
                const f32x4 v = *(const f32x4*)(Cs + row * CST + c);
                u32x2 o = {pk(v[0], v[1]), pk(v[2], v[3])};
                *(u32x2*)(dst + (size_t)row * 512 + c) = o;
            }
        } else {
            const float* tab = (const float*)(ws + O_TABM);
            bf16_t* kb = (bf16_t*)(ws + A0_KB);
            if (l31 < 8) {
#pragma unroll 1
                for (int i = 0; i < 16; ++i) {
                    const int row = w * 32 + 2 * i + h2;
                    f32x4 v = *(const f32x4*)(Cs + row * CST + c);
                    if (lat) {
                        const f32x4 pv = *(const f32x4*)(Cs + row * CST + (c ^ 8));
                        const int s = t0 + row - CTXL; const int pos = c < 16 ? (s >> 6) : (s & 63);
                        v = rope4(v, pv, tab + (size_t)(pos * 8 + (c & 7)) * 2, (c & 8) != 0);
                    }
                    u32x2 o = {pk(v[0], v[1]), pk(v[2], v[3])};
#pragma unroll
                    for (int h = 0; h < 8; ++h) *(u32x2*)(kb + ((size_t)(b * 8 + h) * TT + t0 + row) * 96 + 64 + c) = o;
                }
            }
        }
    }
};

struct EpiUq {
    Params p;
    DI void operator()(const float* Cs, char* lds, int g0, int nt) const {
        int tid = threadIdx.x; asm volatile("" : "+v"(tid)); const int lane = tid & 63, w = tid >> 6, l31 = lane & 31, h2 = lane >> 5;
        const int b = g0 / TT, t0 = g0 - b * TT; const bool lat = t0 >= CTXL; const int c = 4 * l31;
        char* ws = p.ws;
        const float* ssq = (const float*)(ws + O_SSQ);
        bf16_t* qb = (bf16_t*)(ws + A0_QB);
        const float* tab = (const float*)(ws + O_TABM);
        const float qscale = 0.10206207261596575f * 1.4426950408889634f;
#pragma unroll 1
        for (int i = 0; i < 16; ++i) {
            const int row = w * 32 + 2 * i + h2; const int g = g0 + row;
            const float rs = rsqrtf((ssq[(size_t)g * 8] + ssq[(size_t)g * 8 + 1] + ssq[(size_t)g * 8 + 2]) * (1.f / 384.f) + EPS) * qscale;
            f32x4 v = *(const f32x4*)(Cs + row * CST + c);
            int head, j;
            if (nt < 4) { head = nt * 2 + (c >> 6); j = c & 63; }
            else {
                head = (nt - 4) * 4 + (c >> 5); const int jj = c & 31; j = 64 + jj;
                if (lat) {
                    const f32x4 pv = *(const f32x4*)(Cs + row * CST + (c ^ 8));
                    const int s = t0 + row - CTXL; const int pos = jj < 16 ? (s >> 6) : (s & 63);
                    v = rope4(v, pv, tab + (size_t)(pos * 8 + (jj & 7)) * 2, (jj & 8) != 0);
                }
            }
            v = v * rs;
            u32x2 o = {pk(v[0], v[1]), pk(v[2], v[3])};
            *(u32x2*)(qb + ((size_t)(b * 8 + head) * TT + t0 + row) * 96 + j) = o;
        }
    }
};

struct EpiUkv {
    Params p;
    DI void operator()(const float* Cs, char* lds, int g0, int nt) const {
        int tid = threadIdx.x; asm volatile("" : "+v"(tid)); const int lane = tid & 63, w = tid >> 6, l31 = lane & 31, h2 = lane >> 5;
        const int b = g0 / TT, t0 = g0 - b * TT; const int c = 4 * l31;
        char* ws = p.ws;
        const float* ssq = (const float*)(ws + O_SSQ);
        float* rsl = (float*)(lds + EPI_AUX);
        if (tid < 128) { const int g = g0 + tid; rsl[tid] = rsqrtf((ssq[(size_t)g * 8 + 3] + ssq[(size_t)g * 8 + 4]) * (1.f / 256.f) + EPS); }
        __syncthreads();
        bf16_t* kb = (bf16_t*)(ws + A0_KB);
        if (l31 < 16) {
#pragma unroll 1
            for (int i = 0; i < 16; ++i) {
                const int row = w * 32 + 2 * i + h2;
                f32x4 v = *(const f32x4*)(Cs + row * CST + c); v = v * rsl[row];
                u32x2 o = {pk(v[0], v[1]), pk(v[2], v[3])};
                *(u32x2*)(kb + ((size_t)(b * 8 + nt) * TT + t0 + row) * 96 + c) = o;
            }
        }
        twrite<64>(Cs, 64, (bf16_t*)(ws + A0_VT) + ((size_t)(b * 8 + nt) * 64) * TT + t0, TT, rsl);
    }
};

struct EpiResid {
    Params p; int layer, gate_chunk, from_input, partial, lazy, lnl, lnw;
    DI void operator()(const float* Cs, char* lds, int g0, int ntv) const {
        int tid = threadIdx.x; asm volatile("" : "+v"(tid)); const int lane = tid & 63, w = tid >> 6, l31 = lane & 31, h2 = lane >> 5;
        const int c = 4 * l31;
        if (partial) {
            const int part = ntv >> 3, nt = ntv & 7;
            const int b = g0 / TT, t0 = g0 - b * TT;
            float* dst = (float*)(p.ws + O_PART) + ((size_t)part * 1024 + b * CTXL + t0) * DM + nt * 128 + c;
#pragma unroll 4
            for (int i = 0; i < 16; ++i) { const int row = w * 32 + 2 * i + h2; *(f32x4*)(dst + (size_t)row * DM) = *(const f32x4*)(Cs + row * CST + c); }
            return;
        }
        const int nt = ntv; const int mi = modidx(g0);
        const float* gate = (const float*)(p.ws + O_MODV) + (size_t)(layer * 5 + mi) * 6144 + gate_chunk * 1024 + nt * 128 + c;
        const f32x4 gv = *(const f32x4*)gate;
        f32x4 lgv = {1.f, 1.f, 1.f, 1.f}, lbv = {0.f, 0.f, 0.f, 0.f};
        const float* st = (const float*)(p.ws + O_STATS) + (size_t)(lazy > 0 ? lazy - 1 : 0) * RT * 8;
        if (lazy > 0) { lgv = *(const f32x4*)(p.ln_g + (size_t)(lnl * 2 + lnw) * 1024 + nt * 128 + c); lbv = *(const f32x4*)(p.ln_b + (size_t)(lnl * 2 + lnw) * 1024 + nt * 128 + c); }
#pragma unroll 8
        for (int i = 0; i < 16; ++i) {
            const int row = w * 32 + 2 * i + h2; const int g = g0 + row;
            const f32x4 v = *(const f32x4*)(Cs + row * CST + c);
            float* xd = xrow(p, g) + nt * 128 + c;
            const float* xs = from_input ? xrow_in(p, g) + nt * 128 + c : xd;
            f32x4 xv = *(const f32x4*)xs;
            if (lazy > 0) { const float mu = __hip_atomic_load(st + (size_t)g * 8, __ATOMIC_RELAXED, __HIP_MEMORY_SCOPE_AGENT), rs = __hip_atomic_load(st + (size_t)g * 8 + 1, __ATOMIC_RELAXED, __HIP_MEMORY_SCOPE_AGENT); xv = (xv - mu) * rs * lgv + lbv; }
            *(f32x4*)xd = xv * ALPHA + gv * v;
        }
    }
};

struct EpiFfIn {
    Params p;
    DI void operator()(const float* Cs, char* lds, int g0, int nt) const {
        int tid = threadIdx.x; asm volatile("" : "+v"(tid)); const int lane = tid & 63, w = tid >> 6;
        const int c = 4 * (lane & 15);
        bf16_t* act = (bf16_t*)(p.ws + O_ACT);
#pragma unroll 4
        for (int i = 0; i < 8; ++i) {
            const int row = w * 32 + i * 4 + (lane >> 4);
            const f32x4 up = *(const f32x4*)(Cs + row * CST + c), gt = *(const f32x4*)(Cs + row * CST + 64 + c);
            u32x2 o = {pk(siluf(gt[0]) * up[0], siluf(gt[1]) * up[1]), pk(siluf(gt[2]) * up[2], siluf(gt[3]) * up[3])};
            *(u32x2*)(act + (size_t)(g0 + row) * DFF + nt * 64 + c) = o;
        }
    }
};

DI float logsigmoidf(float x) { return fminf(x, 0.f) - log1pf(__expf(-fabsf(x))); }

struct EpiMIn {
    static constexpr bool PREFETCH = false;
    Params p;
    DI void operator()(const float* Cs, char* lds, int g0, int nt) const {
        int tid = threadIdx.x; asm volatile("" : "+v"(tid)); const int lane = tid & 63, w = tid >> 6, l31 = lane & 31, h2 = lane >> 5;
        const int b = g0 / TT, t0 = g0 - b * TT; const int c = 4 * l31;
        char* ws = p.ws;
        if (nt < 8) {
            const int ch = nt * 128 + c;
            bf16_t* dst = (bf16_t*)(ws + A1_QKPRE) + (size_t)g0 * 1024 + ch;
            float* halo = (float*)(ws + A1_HALO) + (size_t)(g0 >> 7) * 4 * 1024 + ch;
            const f32x4 w0 = *(const f32x4*)(p.m_conv_w + ch), w1 = *(const f32x4*)(p.m_conv_w + 1024 + ch), w2 = *(const f32x4*)(p.m_conv_w + 2048 + ch), bb = *(const f32x4*)(p.m_conv_b + ch);
            const float scl = nt >= 4 ? 0.125f : 1.f;
#pragma unroll 1
            for (int i = 0; i < 16; ++i) {
                const int row = w * 32 + 2 * i + h2;
                const f32x4 x0 = *(const f32x4*)(Cs + row * CST + c);
                if (row == 0 || row == 1 || row == 126 || row == 127) *(f32x4*)(halo + (size_t)(row < 2 ? row : row - 124) * 1024) = x0;
                if (row >= 1 && row <= 126) {
                    const f32x4 xm = *(const f32x4*)(Cs + (row - 1) * CST + c), xp = *(const f32x4*)(Cs + (row + 1) * CST + c);
                    const f32x4 a = xm * w0 + x0 * w1 + xp * w2 + bb;
                    u32x2 o = {pk(siluf(a[0]) * scl, siluf(a[1]) * scl), pk(siluf(a[2]) * scl, siluf(a[3]) * scl)};
                    *(u32x2*)(dst + (size_t)row * 1024) = o;
                }
            }
        } else if (nt >= 16 && nt < 24) {
            bf16_t* dst = (bf16_t*)(ws + A1_OG) + (size_t)g0 * 1024 + (nt - 16) * 128;
#pragma unroll 1
            for (int i = 0; i < 16; ++i) {
                const int row = w * 32 + 2 * i + h2;
                const f32x4 v = *(const f32x4*)(Cs + row * CST + c);
                u32x2 o = {pk(v[0], v[1]), pk(v[2], v[3])};
                *(u32x2*)(dst + (size_t)row * 1024 + c) = o;
            }
        } else if (nt < 16) {
            twrite<128>(Cs, 0, (bf16_t*)(ws + A1_VT) + ((size_t)(b * 8 + (nt - 8)) * 128) * TT + t0, TT, nullptr);
        } else {
            float* mg = (float*)(ws + A1_G);
            if (l31 < 8) {
                const f32x4 gb = *(const f32x4*)(p.m_gate_b + c);
                const bool ls = ((c >> 3) & 1) != 0;
#pragma unroll 1
                for (int i = 0; i < 16; ++i) {
                    const int row = w * 32 + 2 * i + h2;
                    f32x4 v = *(const f32x4*)(Cs + row * CST + c); v = v + gb;
                    if (ls) { v[0] = logsigmoidf(v[0]); v[1] = logsigmoidf(v[1]); v[2] = logsigmoidf(v[2]); v[3] = logsigmoidf(v[3]); }
                    *(f32x4*)(mg + (size_t)(g0 + row) * 32 + c) = v;
                }
            }
        }
    }
};

DI f32x4 ld_nt(const float* q) { return __builtin_nontemporal_load((const f32x4*)q); }
DI void ln_phase(const Params& p, int layer, int which, int next_layer, int next_chunk  , int latonly, int bid, int nb, int nparts = 0, int gate_chunk = 0, int from_input = 0, int lazy_out = 0  , int lazy_src = 0  ) {
    const int tid = threadIdx.x, lane = tid & 63;
    const float* lg = p.ln_g + (size_t)(layer * 2 + which) * 1024; const float* lb = p.ln_b + (size_t)(layer * 2 + which) * 1024;
    const float* modv = (const float*)(p.ws + O_MODV);
    bf16_t* H = (bf16_t*)(p.ws + O_H);
    const int nrows = latonly ? NB * SEQ : RT;
    f32x4 gv[4], bv[4];
#pragma unroll
    for (int i = 0; i < 4; ++i) { gv[i] = *(const f32x4*)(lg + i * 256 + lane * 4); bv[i] = *(const f32x4*)(lb + i * 256 + lane * 4); }
    for (int r = bid * 4 + (tid >> 6); r < nrows; r += nb * 4) {
        const int g = latonly ? ((r >> 13) * TT + CTXL + (r & 8191)) : r;
        float* xr = xrow(p, g);
        f32x4 v[4]; float s = 0.f;
        const int tloc = g % TT;
        const bool assembled = nparts > 0 && tloc < CTXL;
        if (nparts > 0 && tloc < CTXL) {
            const float* xs = from_input ? xrow_in(p, g) : xr;
            const float* gate = modv + (size_t)(layer * 5 + 4) * 6144 + gate_chunk * 1024;
            const float* pp = (const float*)(p.ws + O_PART) + (size_t)((g / TT) * CTXL + tloc) * DM;
#pragma unroll
            for (int i = 0; i < 4; ++i) {
                f32x4 acc = *(const f32x4*)(pp + i * 256 + lane * 4);
                for (int q = 1; q < nparts; ++q) acc = acc + *(const f32x4*)(pp + (size_t)q * 1024 * DM + i * 256 + lane * 4);
                f32x4 xv = *(const f32x4*)(xs + i * 256 + lane * 4);
                if (lazy_src > 0) {
                    const float* st = (const float*)(p.ws + O_STATS) + (size_t)(lazy_src - 1) * RT * 8 + (size_t)g * 8;
                    const float mu0 = __hip_atomic_load(st, __ATOMIC_RELAXED, __HIP_MEMORY_SCOPE_AGENT), rs0 = __hip_atomic_load(st + 1, __ATOMIC_RELAXED, __HIP_MEMORY_SCOPE_AGENT);
                    const f32x4 g4 = *(const f32x4*)(p.ln_g + (size_t)(layer * 2 + 0) * 1024 + i * 256 + lane * 4), b4 = *(const f32x4*)(p.ln_b + (size_t)(layer * 2 + 0) * 1024 + i * 256 + lane * 4);
                    xv = (xv - mu0) * rs0 * g4 + b4;
                }
                v[i] = xv * ALPHA + *(const f32x4*)(gate + i * 256 + lane * 4) * acc;
            }
        } else {
#pragma unroll
            for (int i = 0; i < 4; ++i) v[i] = ld_nt(xr + i * 256 + lane * 4);
        }
#pragma unroll
        for (int i = 0; i < 4; ++i) s += (v[i][0] + v[i][1]) + (v[i][2] + v[i][3]);
#pragma unroll
        for (int o = 1; o < 64; o <<= 1) s += __shfl_xor(s, o);
        const float mu = s * (1.f / 1024.f); float q = 0.f;
#pragma unroll
        for (int i = 0; i < 4; ++i) { v[i] = v[i] - mu; q += (v[i][0] * v[i][0] + v[i][1] * v[i][1]) + (v[i][2] * v[i][2] + v[i][3] * v[i][3]); }
#pragma unroll
        for (int o = 1; o < 64; o <<= 1) q += __shfl_xor(q, o);
        const float rstd = rsqrtf(q * (1.f / 1024.f) + EPS);
        if (lazy_out > 0 && lane == 0) { float* st = (float*)(p.ws + O_STATS) + (size_t)(lazy_out - 1) * RT * 8 + (size_t)g * 8; __hip_atomic_store(st, mu, __ATOMIC_RELAXED, __HIP_MEMORY_SCOPE_AGENT); __hip_atomic_store(st + 1, rstd, __ATOMIC_RELAXED, __HIP_MEMORY_SCOPE_AGENT); }
        const int mi = modidx(g);
        const float* sh = modv + (size_t)(next_layer * 5 + mi) * 6144 + (next_chunk < 0 ? 0 : next_chunk) * 1024; const float* sc = sh + 1024;
#pragma unroll
        for (int i = 0; i < 4; ++i) {
            const f32x4 y = v[i] * rstd * gv[i] + bv[i];
            if (lazy_out == 0) *(f32x4*)(xr + i * 256 + lane * 4) = y;
            else if (assembled) *(f32x4*)(xr + i * 256 + lane * 4) = v[i] + mu;
            if (next_chunk >= 0) {
                const f32x4 s4 = *(const f32x4*)(sh + i * 256 + lane * 4), c4 = *(const f32x4*)(sc + i * 256 + lane * 4);
                const f32x4 h = y * (1.f + c4) + s4;
                u32x2 o = {pk(h[0], h[1]), pk(h[2], h[3])};
                *(u32x2*)(H + (size_t)g * 1024 + i * 256 + lane * 4) = o;
            }
        }
    }
}

DI void attn_softmax(f32x16 (&s)[2], float& m, float& l, f32x16 (&o)[2]) {
    float mx = fmaxf(s[0][0], s[1][0]);
#pragma unroll
    for (int r = 1; r < 16; ++r) mx = fmaxf(mx, fmaxf(s[0][r], s[1][r]));
    if (__builtin_amdgcn_ballot_w64(mx > m + 8.f) != 0ull) {
        mx = fmaxf(mx, __shfl_xor(mx, 32));
        const float mn = fmaxf(m, mx); const float alpha = __builtin_amdgcn_exp2f(m - mn); m = mn;
        l *= alpha;
#pragma unroll
        for (int r = 0; r < 16; ++r) { o[0][r] *= alpha; o[1][r] *= alpha; }
    }
    float ps = 0.f;
#pragma unroll
    for (int r = 0; r < 16; ++r) { s[0][r] = __builtin_amdgcn_exp2f(s[0][r] - m); s[1][r] = __builtin_amdgcn_exp2f(s[1][r] - m); ps += s[0][r] + s[1][r]; }
    l += ps;
}
DI void attn_pack(const f32x16 (&s)[2], s16x8 (&pf)[4]) {
#pragma unroll
    for (int kb = 0; kb < 2; ++kb)
#pragma unroll
        for (int sp = 0; sp < 2; ++sp)
            pf[kb * 2 + sp] = pack8(s[kb][8 * sp], s[kb][8 * sp + 1], s[kb][8 * sp + 2], s[kb][8 * sp + 3], s[kb][8 * sp + 4], s[kb][8 * sp + 5], s[kb][8 * sp + 6], s[kb][8 * sp + 7]);
}
DI void attn_pv(const s16x8 (&pf)[4], f32x16 (&o)[2], const bf16_t* Vc, int VST) {
#pragma unroll
    for (int kk = 0; kk < 4; ++kk) {
        const int ko = kk * 16;
#pragma unroll
        for (int vb = 0; vb < 2; ++vb) {
            const s16x4 lo = *(const s16x4*)(Vc + vb * 32 * VST + ko), hi = *(const s16x4*)(Vc + vb * 32 * VST + ko + 8);
            o[vb] = MFMA32(cat4(lo, hi), pf[kk], o[vb]);
        }
    }
}
DI void attn_sm2(f32x16 (&s)[2], float& m, float& l, f32x16 (&o)[2], s16x8 (&pf)[4]) {
    constexpr float THR = 4.f;
    float mx = s[0][0];
#pragma unroll
    for (int r = 0; r < 16; ++r) { mx = fmaxf(mx, s[0][r]); mx = fmaxf(mx, s[1][r]); }
    mx = fmaxf(mx, __shfl_xor(mx, 32));
    if (__builtin_amdgcn_ballot_w64(mx > m + THR) != 0ull) {
        const float mn = fmaxf(m, mx); const float alpha = __builtin_amdgcn_exp2f(m - mn); m = mn;
        l *= alpha;
#pragma unroll
        for (int r = 0; r < 16; ++r) { o[0][r] *= alpha; o[1][r] *= alpha; }
    }
    float ps = 0.f;
#pragma unroll
    for (int r = 0; r < 16; ++r) { s[0][r] = __builtin_amdgcn_exp2f(s[0][r] - m); s[1][r] = __builtin_amdgcn_exp2f(s[1][r] - m); ps += s[0][r] + s[1][r]; }
    l += ps;
#pragma unroll
    for (int kb = 0; kb < 2; ++kb)
#pragma unroll
        for (int sp = 0; sp < 2; ++sp)
            pf[kb * 2 + sp] = pack8(s[kb][8 * sp], s[kb][8 * sp + 1], s[kb][8 * sp + 2], s[kb][8 * sp + 3], s[kb][8 * sp + 4], s[kb][8 * sp + 5], s[kb][8 * sp + 6], s[kb][8 * sp + 7]);
}
DI void attn_pv2(const s16x8 (&pf)[4], f32x16 (&o)[2], const bf16_t* Vc, int VST) {
#pragma unroll
    for (int kk = 0; kk < 4; ++kk)
#pragma unroll
        for (int vb = 0; vb < 2; ++vb) {
            const s16x4 lo = *(const s16x4*)(Vc + vb * 32 * VST + kk * 16), hi = *(const s16x4*)(Vc + vb * 32 * VST + kk * 16 + 8);
            o[vb] = MFMA32(cat4(lo, hi), pf[kk], o[vb]);
        }
}
DI void attn_phase(const Params& p, char* lds, int bid, int nb) {
    constexpr int KST = 104, VST = 68;
    bf16_t* Ks = (bf16_t*)lds;
    bf16_t* Vs = Ks + 2 * 64 * KST;
    bf16_t* Qs = Vs + 2 * 64 * VST;
    const int tid = threadIdx.x, lane = tid & 63, w = tid >> 6, l31 = lane & 31, h2 = lane >> 5;
    char* ws = p.ws;
    const bf16_t* QB = (const bf16_t*)(ws + A0_QB); const bf16_t* KB = (const bf16_t*)(ws + A0_KB); const bf16_t* VT = (const bf16_t*)(ws + A0_VT);
    bf16_t* MIX = (bf16_t*)(ws + O_H);
    const int xcd = bid & 7, j = bid >> 3, per = nb >> 3;
    const int nlat = 128;
    for (int uu = j; uu < nlat + 4; uu += per) {
        int b, h, q0, nkt;
        if (uu < nlat) { const int bh = xcd + 8 * (uu >> 5); b = bh >> 3; h = bh & 7; q0 = CTXL + (uu & 31) * 256; nkt = TT / 64; }
        else { const int bh = xcd + 8 * (uu - nlat); b = bh >> 3; h = bh & 7; q0 = 0; nkt = CTXL / 64; }
        const size_t bh_ = (size_t)(b * 8 + h);
        const bf16_t* Qg = QB + (bh_ * TT + q0 + w * 64 + l31) * 96 + h2 * 8;
        s16x8 qfA[6];
        bf16_t* Qb = Qs + (w * 32 + l31) * KST + h2 * 8;
#pragma unroll
        for (int ks = 0; ks < 6; ++ks) { qfA[ks] = *(const s16x8*)(Qg + ks * 16); *(s16x8*)(Qb + ks * 16) = *(const s16x8*)(Qg + 32 * 96 + ks * 16); }
        const bf16_t* Kg = KB + bh_ * TT * 96;
        const bf16_t* Vg = VT + bh_ * 64 * TT;
        f32x16 oA[2], oB[2]; zero16(oA[0]); zero16(oA[1]); zero16(oB[0]); zero16(oB[1]);
        float mA = -1e30f, lA = 0.f, mB = -1e30f, lB = 0.f;
        u32x4 rk[3], rv[2];
#pragma unroll
        for (int i = 0; i < 3; ++i) { const int idx = tid + 256 * i; rk[i] = *(const u32x4*)(Kg + (size_t)idx * 8); }
#pragma unroll
        for (int i = 0; i < 2; ++i) { const int idx = tid + 256 * i, r = idx >> 3, c8 = idx & 7; rv[i] = *(const u32x4*)(Vg + (size_t)r * TT + c8 * 8); }
#pragma unroll
        for (int i = 0; i < 3; ++i) { const int idx = tid + 256 * i, r = idx / 12, c8 = idx - r * 12; *(u32x4*)(Ks + r * KST + c8 * 8) = rk[i]; }
#pragma unroll
        for (int i = 0; i < 2; ++i) { const int idx = tid + 256 * i, r = idx >> 3, c8 = idx & 7;
            u32x2 a = {rv[i][0], rv[i][1]}, bq = {rv[i][2], rv[i][3]};
            *(u32x2*)(Vs + r * VST + c8 * 8) = a; *(u32x2*)(Vs + r * VST + c8 * 8 + 4) = bq; }
        __syncthreads();
#pragma unroll 1
        for (int kt = 0; kt < nkt; ++kt) {
            const int cur = kt & 1;
            {
                const int kn = kt + 1 < nkt ? kt + 1 : kt;
                const bf16_t* Kn = Kg + (size_t)kn * 64 * 96; const bf16_t* Vn = Vg + kn * 64;
#pragma unroll
                for (int i = 0; i < 3; ++i) { const int idx = tid + 256 * i; rk[i] = *(const u32x4*)(Kn + (size_t)idx * 8); }
#pragma unroll
                for (int i = 0; i < 2; ++i) { const int idx = tid + 256 * i, r = idx >> 3, c8 = idx & 7; rv[i] = *(const u32x4*)(Vn + (size_t)r * TT + c8 * 8); }
            }
            const bf16_t* Kc = Ks + cur * 64 * KST + l31 * KST + h2 * 8;
            const bf16_t* Vc = Vs + cur * 64 * VST + l31 * VST + 4 * h2;
            s16x8 pfA[4], pfB[4];
            {
                f32x16 sA[2]; zero16(sA[0]); zero16(sA[1]);
#pragma unroll
                for (int ks = 0; ks < 6; ++ks) {
                    const s16x8 a0 = *(const s16x8*)(Kc + ks * 16), a1 = *(const s16x8*)(Kc + 32 * KST + ks * 16);
                    sA[0] = MFMA32(a0, qfA[ks], sA[0]); sA[1] = MFMA32(a1, qfA[ks], sA[1]);
                }
                attn_sm2(sA, mA, lA, oA, pfA);
            }
            __builtin_amdgcn_sched_barrier(0);
            {
                f32x16 sB[2]; zero16(sB[0]); zero16(sB[1]);
#pragma unroll 2
                for (int ks = 0; ks < 6; ++ks) {
                    const s16x8 a0 = *(const s16x8*)(Kc + ks * 16), a1 = *(const s16x8*)(Kc + 32 * KST + ks * 16);
                    const s16x8 qb = *(const s16x8*)(Qb + ks * 16);
                    sB[0] = MFMA32(a0, qb, sB[0]); sB[1] = MFMA32(a1, qb, sB[1]);
                }
                attn_pv2(pfA, oA, Vc, VST);
                attn_sm2(sB, mB, lB, oB, pfB);
            }
            __builtin_amdgcn_sched_barrier(0);
            attn_pv2(pfB, oB, Vc, VST);
            {
                bf16_t* Kw = Ks + (cur ^ 1) * 64 * KST; bf16_t* Vw = Vs + (cur ^ 1) * 64 * VST;
#pragma unroll
                for (int i = 0; i < 3; ++i) { const int idx = tid + 256 * i, r = idx / 12, c8 = idx - r * 12; *(u32x4*)(Kw + r * KST + c8 * 8) = rk[i]; }
#pragma unroll
                for (int i = 0; i < 2; ++i) { const int idx = tid + 256 * i, r = idx >> 3, c8 = idx & 7;
                    u32x2 a = {rv[i][0], rv[i][1]}, bq = {rv[i][2], rv[i][3]};
                    *(u32x2*)(Vw + r * VST + c8 * 8) = a; *(u32x2*)(Vw + r * VST + c8 * 8 + 4) = bq; }
            }
            __syncthreads();
        }
        lA += __shfl_xor(lA, 32); lB += __shfl_xor(lB, 32);
        const float invA = __builtin_amdgcn_rcpf(lA), invB = __builtin_amdgcn_rcpf(lB);
        bf16_t* dst = MIX + ((size_t)b * TT + q0 + w * 64 + l31) * 1024 + h * 64 + 4 * h2;
#pragma unroll
        for (int vb = 0; vb < 2; ++vb)
#pragma unroll
            for (int rg = 0; rg < 4; ++rg) {
                u32x2 ov = {pk(oA[vb][4 * rg] * invA, oA[vb][4 * rg + 1] * invA), pk(oA[vb][4 * rg + 2] * invA, oA[vb][4 * rg + 3] * invA)};
                *(u32x2*)(dst + vb * 32 + rg * 8) = ov;
                u32x2 ow = {pk(oB[vb][4 * rg] * invB, oB[vb][4 * rg + 1] * invB), pk(oB[vb][4 * rg + 2] * invB, oB[vb][4 * rg + 3] * invB)};
                *(u32x2*)(dst + (size_t)32 * 1024 + vb * 32 + rg * 8) = ow;
            }
    }
}

constexpr int RST = 136;
DI void load_tile128(bf16_t* dstl, const bf16_t* src, size_t ld) {
    const int tid = threadIdx.x;
#pragma unroll
    for (int i = 0; i < 8; ++i) { const int idx = tid + 256 * i, r = idx >> 4, c8 = idx & 15;
        *(u32x4*)(dstl + r * RST + c8 * 8) = *(const u32x4*)(src + (size_t)r * ld + c8 * 8); }
}
DI void ret_u_phase(const Params& p, char* lds, int bid, int nb) {
    bf16_t* Vt = (bf16_t*)lds;
    bf16_t* Kt = Vt + 128 * RST;
    const int tid = threadIdx.x, lane = tid & 63, w = tid >> 6, l31 = lane & 31, h2 = lane >> 5;
    char* ws = p.ws;
    const bf16_t* RK = (const bf16_t*)(ws + A0_RK); const bf16_t* RVT = (const bf16_t*)(ws + A0_RVT);
    bf16_t* RUS = (bf16_t*)(ws + A0_RUS);
    for (int u = bid; u < NB * 4 * 66; u += nb) {
        const int c = u % 66, bh = u / 66, h = bh & 3, b = bh >> 2;
        const int g0 = b * TT + c * 128;
        load_tile128(Vt, RVT + ((size_t)(b * 4 + h) * 128) * TT + c * 128, TT);
        const int pos = tid & 127, half = tid >> 7;
        u32x4 kr[8];
        const bf16_t* ksrc = RK + (size_t)(g0 + pos) * 512 + h * 128 + half * 64;
#pragma unroll
        for (int i = 0; i < 8; ++i) kr[i] = *(const u32x4*)(ksrc + i * 8);
        for (int dir = 0; dir < 2; ++dir) {
            const float lg = p.ret_ld[dir * 4 + h];
            const float wgt = __expf(lg * (dir == 0 ? (float)(127 - pos) : (float)pos));
            if (dir == 1) __syncthreads();
#pragma unroll
            for (int i = 0; i < 8; ++i)
#pragma unroll
                for (int e = 0; e < 4; ++e) {
                    const unsigned uu = kr[i][e];
                    Kt[(half * 64 + i * 8 + 2 * e) * RST + pos] = f2bf(bflo(uu) * wgt);
                    Kt[(half * 64 + i * 8 + 2 * e + 1) * RST + pos] = f2bf(bfhi(uu) * wgt);
                }
            __syncthreads();
            f32x16 acc[4];
#pragma unroll
            for (int ni = 0; ni < 4; ++ni) zero16(acc[ni]);
            const bf16_t* Ac = Vt + (w * 32 + l31) * RST + h2 * 8;
            const bf16_t* Bc = Kt + l31 * RST + h2 * 8;
#pragma unroll
            for (int ks = 0; ks < 8; ++ks) {
                const s16x8 a = *(const s16x8*)(Ac + ks * 16);
#pragma unroll
                for (int ni = 0; ni < 4; ++ni) { const s16x8 bb = *(const s16x8*)(Bc + ni * 32 * RST + ks * 16); acc[ni] = MFMA32(a, bb, acc[ni]); }
            }
            bf16_t* dst = RUS + ((size_t)((b * 4 + h) * 2 + dir) * 66 + c) * 16384;
#pragma unroll
            for (int ni = 0; ni < 4; ++ni)
#pragma unroll
                for (int r = 0; r < 16; ++r) dst[(w * 32 + crow(r, h2)) * 128 + ni * 32 + l31] = f2bf(acc[ni][r]);
        }
        __syncthreads();
    }
}

DI void ret_scan_phase(const Params& p, int bid, int nb) {
    const unsigned tid = threadIdx.x;
    unsigned* RUS = (unsigned*)(p.ws + A0_RUS);
    for (int blk = bid; blk < 1024; blk += nb) {
        const int seq = blk >> 5;
        const unsigned e = (unsigned)(blk & 31) * 256u + tid;
        const int dir = seq & 1, h = (seq >> 1) & 3;
        const float g128 = __expf(p.ret_ld[dir * 4 + h] * 128.f);
        unsigned* sbase = RUS + (size_t)seq * 66 * 8192;
        float r0 = 0.f, r1 = 0.f;
#pragma unroll 1
        for (int hf = 0; hf < 2; ++hf) {
            unsigned v[33];
#pragma unroll
            for (int j = 0; j < 33; ++j) { const int i = hf * 33 + j; const int c = dir == 0 ? i : (i < 2 ? 1 - i : 67 - i); v[j] = (sbase + (size_t)c * 8192)[e]; }
#pragma unroll
            for (int j = 0; j < 33; ++j) {
                const int i = hf * 33 + j; const int c = dir == 0 ? i : (i < 2 ? 1 - i : 67 - i);
                (sbase + (size_t)c * 8192)[e] = pk(r0, r1);
                r0 = g128 * r0 + bflo(v[j]); r1 = g128 * r1 + bfhi(v[j]);
            }
        }
    }
}

DI void ret_out_phase(const Params& p, char* lds, int bid, int nb) {
    bf16_t* B0 = (bf16_t*)lds;
    bf16_t* Vt = B0 + 128 * RST;
    const int tid = threadIdx.x, lane = tid & 63, w = tid >> 6, l31 = lane & 31, h2 = lane >> 5;
    char* ws = p.ws;
    const bf16_t* RQ = (const bf16_t*)(ws + A0_RQ); const bf16_t* RK = (const bf16_t*)(ws + A0_RK); const bf16_t* RVT = (const bf16_t*)(ws + A0_RVT);
    const bf16_t* RG = (const bf16_t*)(ws + A0_RG); const bf16_t* RUS = (const bf16_t*)(ws + A0_RUS);
    bf16_t* MIX = (bf16_t*)(ws + O_H);
    for (int u = bid; u < NB * 4 * 66; u += nb) {
        const int c = u % 66, bh = u / 66, h = bh & 3, b = bh >> 2;
        const int g0 = b * TT + c * 128;
        const float lgf = p.ret_ld[h] * 1.4426950408889634f, lgb = p.ret_ld[4 + h] * 1.4426950408889634f;
        load_tile128(B0, RK + (size_t)g0 * 512 + h * 128, 512);
        load_tile128(Vt, RVT + ((size_t)(b * 4 + h) * 128) * TT + c * 128, TT);
        const int qi = w * 32 + l31;
        s16x8 qf[8];
        const bf16_t* Qg = RQ + (size_t)(g0 + qi) * 512 + h * 128 + h2 * 8;
#pragma unroll
        for (int ks = 0; ks < 8; ++ks) qf[ks] = *(const s16x8*)(Qg + ks * 16);
        __syncthreads();
        f32x16 o[4];
#pragma unroll
        for (int vb = 0; vb < 4; ++vb) zero16(o[vb]);
#pragma unroll 1
        for (int jb = 0; jb < 4; ++jb) {
            f32x16 s; zero16(s);
            const bf16_t* Kc = B0 + (jb * 32 + l31) * RST + h2 * 8;
#pragma unroll
            for (int ks = 0; ks < 8; ++ks) s = MFMA32(*(const s16x8*)(Kc + ks * 16), qf[ks], s);
#pragma unroll
            for (int r = 0; r < 16; ++r) {
                const int jj = jb * 32 + crow(r, h2); const int d = qi - jj;
                const float dm = d > 0 ? __builtin_amdgcn_exp2f(lgf * (float)d) : (d < 0 ? __builtin_amdgcn_exp2f(lgb * (float)(-d)) : 2.f);
                s[r] *= dm;
            }
#pragma unroll
            for (int sp = 0; sp < 2; ++sp) {
                const s16x8 pf = pack8(s[8 * sp], s[8 * sp + 1], s[8 * sp + 2], s[8 * sp + 3], s[8 * sp + 4], s[8 * sp + 5], s[8 * sp + 6], s[8 * sp + 7]);
                const int ko = jb * 32 + sp * 16 + 4 * h2;
#pragma unroll
                for (int vb = 0; vb < 4; ++vb) {
                    const bf16_t* vp = Vt + (vb * 32 + l31) * RST + ko;
                    o[vb] = MFMA32(cat4(*(const s16x4*)vp, *(const s16x4*)(vp + 8)), pf, o[vb]);
                }
            }
        }
#pragma unroll 1
        for (int dir = 0; dir < 2; ++dir) {
            __syncthreads();
            load_tile128(B0, RUS + ((size_t)((b * 4 + h) * 2 + dir) * 66 + c) * 16384, 128);
            const float dq = __builtin_amdgcn_exp2f((dir == 0 ? lgf * (float)(qi + 1) : lgb * (float)(128 - qi)));
            __syncthreads();
#pragma unroll
            for (int ks = 0; ks < 8; ++ks) {
                const u32x4 qq = __builtin_bit_cast(u32x4, qf[ks]);
                const s16x8 qs = pack8(bflo(qq[0]) * dq, bfhi(qq[0]) * dq, bflo(qq[1]) * dq, bfhi(qq[1]) * dq, bflo(qq[2]) * dq, bfhi(qq[2]) * dq, bflo(qq[3]) * dq, bfhi(qq[3]) * dq);
#pragma unroll
                for (int vb = 0; vb < 4; ++vb) o[vb] = MFMA32(*(const s16x8*)(B0 + (vb * 32 + l31) * RST + h2 * 8 + ks * 16), qs, o[vb]);
            }
        }
        float sm = 0.f;
#pragma unroll
        for (int vb = 0; vb < 4; ++vb)
#pragma unroll
            for (int r = 0; r < 16; ++r) sm += o[vb][r];
        sm += __shfl_xor(sm, 32);
        const float mu = sm * (1.f / 128.f); float q = 0.f;
#pragma unroll
        for (int vb = 0; vb < 4; ++vb)
#pragma unroll
            for (int r = 0; r < 16; ++r) { o[vb][r] -= mu; q += o[vb][r] * o[vb][r]; }
        q += __shfl_xor(q, 32);
        const float rstd = rsqrtf(q * (1.f / 128.f) + EPS);
        const bf16_t* gsrc = RG + (size_t)(g0 + qi) * 512 + h * 128 + 4 * h2;
        bf16_t* dst = MIX + (size_t)(g0 + qi) * 1024 + 512 + h * 128 + 4 * h2;
#pragma unroll
        for (int vb = 0; vb < 4; ++vb)
#pragma unroll
            for (int rg = 0; rg < 4; ++rg) {
                const u32x2 gg = *(const u32x2*)(gsrc + vb * 32 + rg * 8);
                const float g0v = siluf(bflo(gg[0])), g1v = siluf(bfhi(gg[0])), g2v = siluf(bflo(gg[1])), g3v = siluf(bfhi(gg[1]));
                u32x2 ov = {pk(g0v * o[vb][4 * rg] * rstd, g1v * o[vb][4 * rg + 1] * rstd), pk(g2v * o[vb][4 * rg + 2] * rstd, g3v * o[vb][4 * rg + 3] * rstd)};
                *(u32x2*)(dst + vb * 32 + rg * 8) = ov;
            }
        __syncthreads();
    }
}

DI void mconv_phase(const Params& p, int bid, int nb) {
    const int tid = threadIdx.x; const int gtid = bid * NTHR + tid, gthreads = nb * NTHR;
    const float* HALO = (const float*)(p.ws + A1_HALO);
    bf16_t* POST = (bf16_t*)(p.ws + A1_QKPRE);
    for (int it = gtid; it < (RT / 128) * 2 * 256; it += gthreads) {
        const int c4 = (it & 255) * 4, which = (it >> 8) & 1, hidx = it >> 9;
        const int hb = hidx % 66;
        const float* hh = HALO + (size_t)hidx * 4 * 1024 + c4;
        const f32x4 z = {0.f, 0.f, 0.f, 0.f};
        f32x4 xm, x0, xp; int row;
        if (which == 0) { row = 0; x0 = *(const f32x4*)hh; xp = *(const f32x4*)(hh + 1024); xm = (hb == 0 || hb == 2) ? z : *(const f32x4*)(hh - 4 * 1024 + 3 * 1024); }
        else { row = 127; xm = *(const f32x4*)(hh + 2 * 1024); x0 = *(const f32x4*)(hh + 3 * 1024); xp = (hb == 1 || hb == 65) ? z : *(const f32x4*)(hh + 4 * 1024); }
        const f32x4 w0 = *(const f32x4*)(p.m_conv_w + c4), w1 = *(const f32x4*)(p.m_conv_w + 1024 + c4), w2 = *(const f32x4*)(p.m_conv_w + 2048 + c4), bb = *(const f32x4*)(p.m_conv_b + c4);
        const float scl = c4 >= 512 ? 0.125f : 1.f;
        const f32x4 a = xm * w0 + x0 * w1 + xp * w2 + bb;
        u32x2 o = {pk(siluf(a[0]) * scl, siluf(a[1]) * scl), pk(siluf(a[2]) * scl, siluf(a[3]) * scl)};
        *(u32x2*)(POST + (size_t)(hidx * 128 + row) * 1024 + c4) = o;
    }
}

constexpr int MST = 72;
DI void mlstm_u_phase(const Params& p, char* lds, int bid, int nb) {
    bf16_t* Vt = (bf16_t*)lds;
    bf16_t* Ktf = Vt + 128 * MST;
    bf16_t* Ktb = Ktf + 64 * MST;
    float* gt = (float*)(Ktb + 64 * MST);
    float* wt = gt + 256; float* scal = wt + 128;
    const int tid = threadIdx.x, lane = tid & 63, w = tid >> 6, l31 = lane & 31, h2 = lane >> 5;
    char* ws = p.ws;
    const bf16_t* QK = (const bf16_t*)(ws + A1_QKPRE); const bf16_t* MVT = (const bf16_t*)(ws + A1_VT); const float* MG = (const float*)(ws + A1_G);
    bf16_t* MU = (bf16_t*)(ws + A1_U); float* MN = (float*)(ws + A1_N); float* MSC = (float*)(ws + A1_SC);
    for (int u = bid; u < NB * 8 * 132; u += nb) {
        const int c = u % 132, bh = u / 132, h = bh & 7, b = bh >> 3;
        const int g0 = b * TT + c * 64;
        { const int kind = tid >> 6, s = tid & 63; gt[kind * 64 + s] = MG[(size_t)(g0 + s) * 32 + kind * 8 + h]; }
#pragma unroll
        for (int i = 0; i < 4; ++i) { const int idx = tid + 256 * i, r = idx >> 3, c8 = idx & 7;
            *(u32x4*)(Vt + r * MST + c8 * 8) = *(const u32x4*)(MVT + ((size_t)(b * 8 + h) * 128 + r) * TT + c * 64 + c8 * 8); }
        const int pos = tid & 63, qd = tid >> 6;
        const bf16_t* ksrc = QK + (size_t)(g0 + pos) * 1024 + 512 + h * 64 + qd * 16;
        const u32x4 k0 = *(const u32x4*)ksrc, k1 = *(const u32x4*)(ksrc + 8);
        __syncthreads();
        if (tid < 2) {
            if (tid == 0) {
                float run = 0.f, mx = -1e30f;
                for (int s = 63; s >= 0; --s) { const float lw = run + gt[s]; wt[s] = lw; mx = fmaxf(mx, lw); run += gt[64 + s]; }
                scal[0] = mx; scal[1] = run;
            } else {
                float run = 0.f, mx = -1e30f;
                for (int s = 0; s < 64; ++s) { const float lw = run + gt[128 + s]; wt[64 + s] = lw; mx = fmaxf(mx, lw); run += gt[192 + s]; }
                scal[2] = mx; scal[3] = run;
            }
        }
        __syncthreads();
        const float wf = __expf(wt[pos] - scal[0]), wb = __expf(wt[64 + pos] - scal[2]);
#pragma unroll
        for (int e = 0; e < 4; ++e) {
            const int dk = qd * 16 + 2 * e;
            Ktf[dk * MST + pos] = f2bf(bflo(k0[e]) * wf); Ktf[(dk + 1) * MST + pos] = f2bf(bfhi(k0[e]) * wf);
            Ktf[(dk + 8) * MST + pos] = f2bf(bflo(k1[e]) * wf); Ktf[(dk + 9) * MST + pos] = f2bf(bfhi(k1[e]) * wf);
            Ktb[dk * MST + pos] = f2bf(bflo(k0[e]) * wb); Ktb[(dk + 1) * MST + pos] = f2bf(bfhi(k0[e]) * wb);
            Ktb[(dk + 8) * MST + pos] = f2bf(bflo(k1[e]) * wb); Ktb[(dk + 9) * MST + pos] = f2bf(bfhi(k1[e]) * wb);
        }
        __syncthreads();
        const size_t sidx0 = (size_t)((b * 8 + h) * 2) * 132 + c;
        if (tid < 128) {
            const int dir = tid >> 6, dk = tid & 63; const bf16_t* row = (dir ? Ktb : Ktf) + dk * MST; float s = 0.f;
            for (int i = 0; i < 64; ++i) s += bf2f(row[i]);
            MN[(sidx0 + dir * 132) * 64 + dk] = s;
        } else if (tid < 130) {
            const int dir = tid - 128;
            MSC[(sidx0 + dir * 132) * 4 + 0] = scal[dir * 2]; MSC[(sidx0 + dir * 132) * 4 + 1] = scal[dir * 2 + 1];
        }
#pragma unroll 1
        for (int dir = 0; dir < 2; ++dir) {
            f32x16 acc[2]; zero16(acc[0]); zero16(acc[1]);
            const bf16_t* Ac = Vt + (w * 32 + l31) * MST + h2 * 8;
            const bf16_t* Bc = (dir ? Ktb : Ktf) + l31 * MST + h2 * 8;
#pragma unroll
            for (int ks = 0; ks < 4; ++ks) {
                const s16x8 a = *(const s16x8*)(Ac + ks * 16);
                acc[0] = MFMA32(a, *(const s16x8*)(Bc + ks * 16), acc[0]); acc[1] = MFMA32(a, *(const s16x8*)(Bc + 32 * MST + ks * 16), acc[1]);
            }
            bf16_t* dst = MU + (sidx0 + dir * 132) * 8192;
#pragma unroll
            for (int ni = 0; ni < 2; ++ni)
#pragma unroll
                for (int r = 0; r < 16; ++r) dst[(w * 32 + crow(r, h2)) * 64 + ni * 32 + l31] = f2bf(acc[ni][r]);
        }
        __syncthreads();
    }
}

DI int mchunk(int dir, int i) { return dir == 0 ? i : (i < 4 ? 3 - i : 135 - i); }
DI void mlstm_scan_phase(const Params& p, char* lds, int bid, int nb) {
    const int tid = threadIdx.x;
    unsigned* MU = (unsigned*)(p.ws + A1_U); float* MN = (float*)(p.ws + A1_N); float* MSC = (float*)(p.ws + A1_SC);
    float* la = (float*)lds;
    float* lu = la + 132;
    float* lml = lu + 132;
    float* lbe = lml + 132;
    for (int blk = bid; blk < 1024; blk += nb) {
        const int seq = blk >> 4;
        const int part = blk & 15;
        const int e = part * 256 + tid; const int dir = seq & 1;
        float* sc = MSC + (size_t)seq * 132 * 4;
        if (tid < 132) { const int c = mchunk(dir, tid); lml[tid] = sc[c * 4]; lbe[tid] = sc[c * 4 + 1]; }
        __syncthreads();
        if (tid == 0) {
            float m = 0.f;
            for (int i = 0; i < 132; ++i) {
                const float mloc = lml[i], bend = lbe[i];
                const float mnew = fmaxf(bend + m, mloc);
                la[i] = __expf(bend + m - mnew); lu[i] = __expf(mloc - mnew);
                if (part == 0) sc[mchunk(dir, i) * 4 + 2] = m;
                m = mnew;
            }
        }
        __syncthreads();
        unsigned* sbase = MU + (size_t)seq * 132 * 4096;
        const unsigned eu = (unsigned)e;
        float r0 = 0.f, r1 = 0.f;
#pragma unroll 1
        for (int hf = 0; hf < 4; ++hf) {
            unsigned v[33];
#pragma unroll
            for (int j = 0; j < 33; ++j) v[j] = (sbase + (size_t)mchunk(dir, hf * 33 + j) * 4096)[eu];
#pragma unroll
            for (int j = 0; j < 33; ++j) {
                const int i = hf * 33 + j;
                (sbase + (size_t)mchunk(dir, i) * 4096)[eu] = pk(r0, r1);
                const float a = la[i], uw = lu[i];
                r0 = a * r0 + uw * bflo(v[j]); r1 = a * r1 + uw * bfhi(v[j]);
            }
        }
        if (part == 1 && tid < 64) {
            float* nbase = MN + (size_t)seq * 132 * 64; float rn = 0.f; const unsigned tu = (unsigned)tid;
#pragma unroll 1
            for (int hf = 0; hf < 4; ++hf) {
                float v[33];
#pragma unroll
                for (int j = 0; j < 33; ++j) v[j] = (nbase + (size_t)mchunk(dir, hf * 33 + j) * 64)[tu];
#pragma unroll
                for (int j = 0; j < 33; ++j) { const int i = hf * 33 + j; (nbase + (size_t)mchunk(dir, i) * 64)[tu] = rn; rn = la[i] * rn + lu[i] * v[j]; }
            }
        }
        __syncthreads();
    }
}

DI void mlstm_out_phase(const Params& p, char* lds, int bid, int nb) {
    bf16_t* Qs = (bf16_t*)lds;
    bf16_t* Ks = Qs + 64 * MST;
    bf16_t* Vt = Ks + 64 * MST;
    bf16_t* Cf = Vt + 128 * MST;
    bf16_t* Cb = Cf + 128 * MST;
    float* HX = (float*)lds;
    float* tb = (float*)(lds + 73728);
    float* tn = tb + 384; float* gt = tn + 128;
    constexpr int HST = 68;
    const int tid = threadIdx.x, lane = tid & 63, w = tid >> 6, l31 = lane & 31, h2 = lane >> 5;
    char* ws = p.ws;
    const bf16_t* QK = (const bf16_t*)(ws + A1_QKPRE); const bf16_t* MVT = (const bf16_t*)(ws + A1_VT); const float* MG = (const float*)(ws + A1_G);
    const bf16_t* MU = (const bf16_t*)(ws + A1_U); const float* MN = (const float*)(ws + A1_N); const float* MSC = (const float*)(ws + A1_SC);
    const bf16_t* OG = (const bf16_t*)(ws + A1_OG); bf16_t* MIXM = (bf16_t*)(ws + O_H);
    u32x4 pq[2], pk_[2], pv[4], pcf[4], pcb[4]; float pg = 0.f, pn = 0.f, pmc = 0.f;
#define MO_LOAD(U) { int tl = threadIdx.x; asm volatile("" : "+v"(tl)); const int cl_ = (U) & 127, bh_ = (U) >> 7, h_ = bh_ & 7, b_ = bh_ >> 3; const int c_ = cl_ + 4; const int g0_ = b_ * TT + c_ * 64; \
        const size_t si_ = (size_t)((b_ * 8 + h_) * 2) * 132 + c_; \
        pg = MG[(size_t)(g0_ + (tl & 63)) * 32 + (tl >> 6) * 8 + h_]; \
        pn = MN[(si_ + ((tl >> 6) & 1) * 132) * 64 + (tl & 63)]; \
        pmc = MSC[(si_ + (tl >> 7) * 132) * 4 + 2]; \
        _Pragma("unroll") for (int i = 0; i < 2; ++i) { const int idx = tl + 256 * i, r = idx >> 3, c8 = idx & 7; \
            pq[i] = *(const u32x4*)(QK + (size_t)(g0_ + r) * 1024 + h_ * 64 + c8 * 8); \
            pk_[i] = *(const u32x4*)(QK + (size_t)(g0_ + r) * 1024 + 512 + h_ * 64 + c8 * 8); } \
        _Pragma("unroll") for (int i = 0; i < 4; ++i) { const int idx = tl + 256 * i, r = idx >> 3, c8 = idx & 7; \
            pv[i] = *(const u32x4*)(MVT + ((size_t)(b_ * 8 + h_) * 128 + r) * TT + c_ * 64 + c8 * 8); \
            pcf[i] = *(const u32x4*)(MU + si_ * 8192 + r * 64 + c8 * 8); \
            pcb[i] = *(const u32x4*)(MU + (si_ + 132) * 8192 + r * 64 + c8 * 8); } }
    if (bid < NB * 8 * 128) MO_LOAD(bid)
    for (int u = bid; u < NB * 8 * 128; u += nb) {
        const int cl = u & 127, bh = u >> 7, h = bh & 7, b = bh >> 3; const int c = cl + 4;
        const int g0 = b * TT + c * 64;
        const size_t sidx0 = (size_t)((b * 8 + h) * 2) * 132 + c;
        int tl2 = threadIdx.x; asm volatile("" : "+v"(tl2));
        gt[tl2] = pg;
        if (tl2 < 128) tn[tl2] = pn;
        const float mc_pre = pmc;
        u32x4 ogpre[4];
        { const bf16_t* ogp = OG + (size_t)(g0 + (tl2 >> 2)) * 1024 + h * 128 + (tl2 & 3) * 32;
#pragma unroll
          for (int i = 0; i < 4; ++i) ogpre[i] = *(const u32x4*)(ogp + i * 8); }
#pragma unroll
        for (int i = 0; i < 2; ++i) { const int idx = tl2 + 256 * i, r = idx >> 3, c8 = idx & 7;
            *(u32x4*)(Qs + r * MST + c8 * 8) = pq[i]; *(u32x4*)(Ks + r * MST + c8 * 8) = pk_[i]; }
#pragma unroll
        for (int i = 0; i < 4; ++i) { const int idx = tl2 + 256 * i, r = idx >> 3, c8 = idx & 7;
            *(u32x4*)(Vt + r * MST + c8 * 8) = pv[i]; *(u32x4*)(Cf + r * MST + c8 * 8) = pcf[i]; *(u32x4*)(Cb + r * MST + c8 * 8) = pcb[i]; }
        __syncthreads();
        if (w < 2) {
            const int sidx = lane;
            float run = gt[(w == 0 ? 64 : 192) + sidx];
            const float gi = gt[(w == 0 ? 0 : 128) + sidx];
            if (w == 0) {
#pragma unroll
                for (int o = 1; o < 64; o <<= 1) { const float v = __shfl_up(run, o); if (lane >= o) run += v; }
            } else {
#pragma unroll
                for (int o = 1; o < 64; o <<= 1) { const float v = __shfl_down(run, o); if (lane + o < 64) run += v; }
            }
            const float a = gi - run; float mx = a;
            if (w == 0) {
#pragma unroll
                for (int o = 1; o < 64; o <<= 1) { const float v = __shfl_up(mx, o); if (lane >= o) mx = fmaxf(mx, v); }
            } else {
#pragma unroll
                for (int o = 1; o < 64; o <<= 1) { const float v = __shfl_down(mx, o); if (lane + o < 64) mx = fmaxf(mx, v); }
            }
            float* T0 = tb + w * 192;
            T0[sidx] = run; T0[64 + sidx] = a; T0[128 + sidx] = mx;
        }
        __syncthreads();
        const int dir = w >> 1, tq = (w & 1) * 32 + l31;
        const float* T = tb + dir * 192;
        const float mc = mc_pre;
        const float bq = T[tq]; const float mt = bq + fmaxf(mc, T[128 + tq]);
        const float et = bq - mt; const float winter = __expf(bq + mc - mt);
        s16x8 qf[4];
#pragma unroll
        for (int ks = 0; ks < 4; ++ks) qf[ks] = *(const s16x8*)(Qs + tq * MST + ks * 16 + h2 * 8);
        f32x16 acc[4];
#pragma unroll
        for (int vb = 0; vb < 4; ++vb) zero16(acc[vb]);
        const bf16_t* Cc = (dir ? Cb : Cf) + l31 * MST + h2 * 8;
#pragma unroll
        for (int ks = 0; ks < 4; ++ks)
#pragma unroll
            for (int vb = 0; vb < 4; ++vb) acc[vb] = MFMA32(*(const s16x8*)(Cc + vb * 32 * MST + ks * 16), qf[ks], acc[vb]);
#pragma unroll
        for (int vb = 0; vb < 4; ++vb)
#pragma unroll
            for (int r = 0; r < 16; ++r) acc[vb][r] *= winter;
        float qn = 0.f;
        { const float* nv = tn + dir * 64 + h2 * 32; const bf16_t* qr = Qs + tq * MST + h2 * 32;
#pragma unroll
          for (int d = 0; d < 32; d += 2) { const unsigned uu = *(const unsigned*)(qr + d); qn += bflo(uu) * nv[d] + bfhi(uu) * nv[d + 1]; } }
        qn += __shfl_xor(qn, 32);
        float den = 0.f;
        f32x16 s[2]; zero16(s[0]); zero16(s[1]);
        const bf16_t* Kc = Ks + l31 * MST + h2 * 8;
#pragma unroll
        for (int ks = 0; ks < 4; ++ks) { s[0] = MFMA32(*(const s16x8*)(Kc + ks * 16), qf[ks], s[0]); s[1] = MFMA32(*(const s16x8*)(Kc + 32 * MST + ks * 16), qf[ks], s[1]); }
#pragma unroll
        for (int sb = 0; sb < 2; ++sb)
#pragma unroll
            for (int r = 0; r < 16; ++r) {
                const int sp = sb * 32 + crow(r, h2);
                const bool ok = dir == 0 ? (sp <= tq) : (sp >= tq);
                const float g = ok ? __expf(et + T[64 + sp]) : 0.f;
                s[sb][r] *= g; den += s[sb][r];
            }
        den += __shfl_xor(den, 32);
        den += winter * qn;
#pragma unroll
        for (int sb = 0; sb < 2; ++sb)
#pragma unroll
            for (int sp = 0; sp < 2; ++sp) {
                const s16x8 pf = pack8(s[sb][8 * sp], s[sb][8 * sp + 1], s[sb][8 * sp + 2], s[sb][8 * sp + 3], s[sb][8 * sp + 4], s[sb][8 * sp + 5], s[sb][8 * sp + 6], s[sb][8 * sp + 7]);
                const int ko = sb * 32 + sp * 16 + 4 * h2;
#pragma unroll
                for (int vb = 0; vb < 4; ++vb) {
                    const bf16_t* vp = Vt + (vb * 32 + l31) * MST + ko;
                    acc[vb] = MFMA32(cat4(*(const s16x4*)vp, *(const s16x4*)(vp + 8)), pf, acc[vb]);
                }
            }
        const float hden = __builtin_amdgcn_rcpf(fmaxf(fabsf(den), __expf(-mt)));
        __syncthreads();
#pragma unroll
        for (int vb = 0; vb < 4; ++vb)
#pragma unroll
            for (int r = 0; r < 16; ++r) HX[(dir * 128 + vb * 32 + crow(r, h2)) * HST + tq] = acc[vb][r] * hden;
        __builtin_amdgcn_sched_barrier(0);
        if (u + nb < NB * 8 * 128) MO_LOAD(u + nb)
        __builtin_amdgcn_sched_barrier(0);
        __syncthreads();
        {
            const int t = tid >> 2, q4 = tid & 3;
            float hv[32]; float sm = 0.f;
#pragma unroll
            for (int i = 0; i < 32; ++i) { const int dv = q4 * 32 + i; hv[i] = HX[dv * HST + t] + HX[(128 + dv) * HST + t]; sm += hv[i]; }
            sm += __shfl_xor(sm, 1); sm += __shfl_xor(sm, 2);
            const float mu = sm * (1.f / 128.f); float q = 0.f;
#pragma unroll
            for (int i = 0; i < 32; ++i) { hv[i] -= mu; q += hv[i] * hv[i]; }
            q += __shfl_xor(q, 1); q += __shfl_xor(q, 2);
            const float rstd = rsqrtf(q * (1.f / 128.f) + EPS);
            const bf16_t* og = OG + (size_t)(g0 + t) * 1024 + h * 128 + q4 * 32;
            bf16_t* mixo = MIXM + (size_t)(g0 + t) * 1024 + h * 128 + q4 * 32;
            const float* ng = p.m_norm_g + h * 128 + q4 * 32;
#pragma unroll
            for (int i = 0; i < 4; ++i) {
                const u32x4 gg = ogpre[i];
                float y[8];
#pragma unroll
                for (int e = 0; e < 4; ++e) {
                    y[2 * e] = sigmf(bflo(gg[e])) * hv[i * 8 + 2 * e] * rstd * ng[i * 8 + 2 * e];
                    y[2 * e + 1] = sigmf(bfhi(gg[e])) * hv[i * 8 + 2 * e + 1] * rstd * ng[i * 8 + 2 * e + 1];
                }
                u32x4 ov = {pk(y[0], y[1]), pk(y[2], y[3]), pk(y[4], y[5]), pk(y[6], y[7])};
                *(u32x4*)(mixo + i * 8) = ov;
            }
        }
        __syncthreads();
    }
}


#undef MO_LOAD
#define XB_TMO      128
#define XB_XCNT(j)  (256  + 64 * (j))
#define XB_XSUB(j)  (1280 + 64 * (j))
#define XB_XGEN(j)  (2304 + 64 * (j))
#define XB_TOP      3328
#define XB_TOPGEN   3392
#define XCD_BAR_WORDS 3456
#define XB_SPIN_CAP (1u << 18)
#define LAS __attribute__((address_space(3)))
DI unsigned xb_ld(unsigned* p)              { return __hip_atomic_load(p, __ATOMIC_RELAXED, __HIP_MEMORY_SCOPE_AGENT); }
DI unsigned xb_add(unsigned* p, unsigned v) { return __hip_atomic_fetch_add(p, v, __ATOMIC_RELAXED, __HIP_MEMORY_SCOPE_AGENT); }
DI unsigned xb_xcc_id() { return (unsigned)__builtin_amdgcn_s_getreg((3 << 11) | 20) & 0xFu; }
#define XB_SPIN(cond, bar) do { unsigned _sp = 0; while (cond) { __builtin_amdgcn_s_sleep(1); \
    if ((++_sp & 255u) == 0u) { if (xb_ld(&(bar)[XB_TMO])) break; if (_sp > XB_SPIN_CAP) { atomicAdd(&(bar)[XB_TMO], 1u); break; } } } } while (0)
struct XcdBarrier { unsigned* bar; unsigned x; volatile LAS unsigned* st; };
DI XcdBarrier xcd_barrier_post(unsigned* bar, volatile LAS unsigned* st) {
    XcdBarrier b; b.bar = bar; b.x = xb_xcc_id(); b.st = st;
    if (threadIdx.x == 0) (void)xb_add(&bar[XB_XCNT(b.x)], 1u);
    return b;
}
DI void xcd_barrier_complete(unsigned* bar, unsigned x, unsigned& nloc, unsigned& nx) {
    const unsigned G = gridDim.x * gridDim.y * gridDim.z;
    unsigned sum, cnt, mine, sp = 0u;
    for (;;) {
        sum = 0u; cnt = 0u; mine = 0u;
#pragma unroll
        for (unsigned j = 0; j < 16; ++j) { const unsigned c = xb_ld(&bar[XB_XCNT(j)]); sum += c; cnt += (c > 0u) ? 1u : 0u; mine = (j == x) ? c : mine; }
        if (sum == G) break;
        __builtin_amdgcn_s_sleep(1);
        if ((++sp & 255u) == 0u) { if (xb_ld(&bar[XB_TMO])) break; if (sp > XB_SPIN_CAP) { atomicAdd(&bar[XB_TMO], 1u); break; } }
    }
    nloc = mine > 0u ? mine : 1u; nx = cnt > 0u ? cnt : 1u;
}
DI void xcd_barrier(const XcdBarrier& b) {
    asm volatile("s_waitcnt vmcnt(0)" ::: "memory");
    __syncthreads();
    if (threadIdx.x == 0) {
        unsigned* bar = b.bar;
        __builtin_amdgcn_s_waitcnt(0);
        unsigned nloc = b.st[0], nx = b.st[1];
        if (nloc == 0u) { xcd_barrier_complete(bar, b.x, nloc, nx); b.st[0] = nloc; b.st[1] = nx; }
        const unsigned old = xb_add(&bar[XB_XSUB(b.x)], 1u);
        const unsigned gen = old / nloc;
        if (old + 1u == (gen + 1u) * nloc) {
            __builtin_amdgcn_fence(__ATOMIC_RELEASE, "agent");
            asm volatile("s_waitcnt vmcnt(0)" ::: "memory");
            const unsigned og = xb_add(&bar[XB_TOP], 1u);
            const unsigned tg = og / nx;
            if (og + 1u == (tg + 1u) * nx) xb_add(&bar[XB_TOPGEN], 1u);
            else XB_SPIN(xb_ld(&bar[XB_TOPGEN]) == tg, bar);
            __builtin_amdgcn_fence(__ATOMIC_ACQUIRE, "agent");
            xb_add(&bar[XB_XGEN(b.x)], 1u);
            asm volatile("s_waitcnt vmcnt(0)" ::: "memory");
        } else {
            XB_SPIN(xb_ld(&bar[XB_XGEN(b.x)]) == gen, bar);
            __builtin_amdgcn_fence(__ATOMIC_ACQUIRE, "agent");
            asm volatile("s_waitcnt vmcnt(0)" ::: "memory");
        }
    }
    __syncthreads();
}

constexpr int NPHASE = 21;
__global__ void __launch_bounds__(NTHR, 2) fwd_kernel(Params p) {
    extern __shared__ __attribute__((aligned(16))) char lds[];
    const int bid = blockIdx.x, nb = gridDim.x;
    char* ws = p.ws;
#if !MULTI_LAUNCH
    cg::grid_group grid = cg::this_grid();
    if (p.ph_hi > 1000) grid.sync();
    volatile LAS unsigned* xst = (volatile LAS unsigned*)(LAS char*)(lds + LDS_BYTES - 16);
    if (threadIdx.x == 0) { xst[0] = 0u; xst[1] = 0u; }
    __syncthreads();
    XcdBarrier xbar = xcd_barrier_post((unsigned*)(ws + O_BAR), xst);
#define SYNC() xcd_barrier(xbar)
#else
#define SYNC() do {} while (0)
#endif
#ifdef ONLY_PHASE
#define PHON(n) ((n) == ONLY_PHASE)
#else
#define PHON(n) true
#endif
#ifndef DUP_MASK
#define DUP_MASK 0u
#endif
#define PHASE(n, ...) if constexpr (PHON(n)) { if (p.ph_lo <= (n) && (n) < p.ph_hi) { if ((n) > p.ph_lo) SYNC(); __VA_ARGS__ if constexpr (((DUP_MASK >> (n)) & 1u) != 0u) { SYNC(); __VA_ARGS__ } } }
    PHASE(0, phase_prologue(p, lds, bid, nb);)
    PHASE(1, phase_modulate0(p, bid, nb);)
    PHASE(2, { GemmArgs ga{(const bf16_t*)(ws + O_H), 1024, (const bf16_t*)(ws + W_ABIN), 1024, 1024, RT / 256, 22, 0, 1}; EpiAbIn e{p}; gemm_phase(ga, e, lds, bid, nb); })
    PHASE(3, {
            GemmArgs g1{(const bf16_t*)(ws + A0_CQ), 384, (const bf16_t*)(ws + W_UQ), 384, 384, RT / 256, 6, 0, 1}; EpiUq e1{p}; gemm_phase(g1, e1, lds, bid, nb);
            GemmArgs g2{(const bf16_t*)(ws + A0_CKV), 256, (const bf16_t*)(ws + W_UKV), 256, 256, RT / 256, 8, 0, 1}; EpiUkv e2{p}; gemm_phase(g2, e2, lds, bid, nb);
            ret_u_phase(p, lds, bid, nb);
        })
    PHASE(4, ret_scan_phase(p, bid, nb);)
    PHASE(5, { attn_phase(p, lds, bid, nb); ret_out_phase(p, lds, bid, nb); })
    PHASE(6, { GemmArgs ga{(const bf16_t*)(ws + O_H), 1024, (const bf16_t*)(ws + W_ABOUT), 1024, 1024, 128, 8, 1, 1}; EpiResid e{p, 0, 2, 1, 0, 0, 0, 0}; gemm_phase(ga, e, lds, bid, nb);
        GemmArgs gc{(const bf16_t*)(ws + O_H), 1024, (const bf16_t*)(ws + W_ABOUT), 1024, 1024, 4, 8, 2, 16}; EpiResid ec{p, 0, 2, 1, 1, 0, 0, 0}; gemm_phase(gc, ec, lds, bid, nb); })
    PHASE(7, ln_phase(p, 0, 0, 0, 3, 0, bid, nb, 16, 2, 1, 1, 0);)
    PHASE(8, { GemmArgs ga{(const bf16_t*)(ws + O_H), 1024, (const bf16_t*)(ws + W_FFIN), 1024, 1024, RT / 256, 44, 0, 1}; EpiFfIn e{p}; gemm_phase(ga, e, lds, bid, nb); })
    PHASE(9, { GemmArgs ga{(const bf16_t*)(ws + O_ACT), DFF, (const bf16_t*)(ws + W_FFOUT), DFF, DFF, 128, 8, 1, 1}; EpiResid e{p, 0, 5, 0, 0, 1, 0, 0}; gemm_phase(ga, e, lds, bid, nb);
        GemmArgs gc{(const bf16_t*)(ws + O_ACT), DFF, (const bf16_t*)(ws + W_FFOUT), DFF, DFF, 4, 8, 2, 11}; EpiResid ec{p, 0, 5, 0, 1, 0, 0, 0}; gemm_phase(gc, ec, lds, bid, nb); })
    PHASE(10, ln_phase(p, 0, 1, 1, 0, 0, bid, nb, 11, 5, 0, 2, 1);)
    PHASE(11, { GemmArgs ga{(const bf16_t*)(ws + O_H), 1024, (const bf16_t*)(ws + W_MIN), 1024, 1024, RT / 256, 25, 0, 1}; EpiMIn e{p}; gemm_phase(ga, e, lds, bid, nb); })
    PHASE(12, mconv_phase(p, bid, nb);)
    PHASE(13, mlstm_u_phase(p, lds, bid, nb);)
    PHASE(14, mlstm_scan_phase(p, lds, bid, nb);)
    PHASE(15, mlstm_out_phase(p, lds, bid, nb);)
    PHASE(16, { GemmArgs ga{(const bf16_t*)(ws + O_H), 1024, (const bf16_t*)(ws + W_MOUT), 1024, 1024, 128, 8, 1, 1}; EpiResid e{p, 1, 2, 0, 0, 2, 0, 1}; gemm_phase(ga, e, lds, bid, nb); })
    PHASE(17, ln_phase(p, 1, 0, 1, 3, 1, bid, nb, 0, 0, 0, 3);)
    PHASE(18, { GemmArgs ga{(const bf16_t*)(ws + O_H), 1024, (const bf16_t*)(ws + W_FFIN) + (size_t)5632 * 1024, 1024, 1024, 128, 44, 1, 1}; EpiFfIn e{p}; gemm_phase(ga, e, lds, bid, nb); })
    PHASE(19, { GemmArgs ga{(const bf16_t*)(ws + O_ACT), DFF, (const bf16_t*)(ws + W_FFOUT) + (size_t)1024 * 2816, DFF, DFF, 128, 8, 1, 1}; EpiResid e{p, 1, 5, 0, 0, 3, 1, 0}; gemm_phase(ga, e, lds, bid, nb); })
    PHASE(20, ln_phase(p, 1, 1, 1, -1, 1, bid, nb);)
}

extern "C" void kernel_launch(void* const* d_in, const int* in_sizes, int n_in, void* d_out, int out_size, void* d_ws, size_t ws_size, hipStream_t stream) {
    static int grid_blocks = 0;
    if (!grid_blocks) {
        int dev = 0, cus = 0, per_cu = 0;
        hipGetDevice(&dev);
        hipDeviceGetAttribute(&cus, hipDeviceAttributeMultiprocessorCount, dev);
        hipFuncSetAttribute((const void*)fwd_kernel, hipFuncAttributeMaxDynamicSharedMemorySize, LDS_BYTES);
        hipOccupancyMaxActiveBlocksPerMultiprocessor(&per_cu, (const void*)fwd_kernel, NTHR, LDS_BYTES);
        if (per_cu < 1) per_cu = 1;
        if (per_cu > 2) per_cu = 2;
        grid_blocks = cus * per_cu;
        if (ws_size < WS_NEED) fprintf(stderr, "kernel_launch: workspace too small: %zu < %zu\n", ws_size, (size_t)WS_NEED);
    }
    Params p{};
    const float** f = (const float**)&p;
    for (int i = 0; i < 23; ++i) f[i] = (const float*)d_in[i];
    p.out = (float*)d_out; p.ws = (char*)d_ws;
#if !MULTI_LAUNCH
    p.ph_lo = 0; p.ph_hi = NPHASE;
    (void)hipMemsetAsync((char*)d_ws + O_BAR, 0, 16384, stream);
    void* args[] = {&p};
    hipError_t e = hipLaunchCooperativeKernel((const void*)fwd_kernel, dim3(grid_blocks), dim3(NTHR), args, LDS_BYTES, stream);
    if (e != hipSuccess) fprintf(stderr, "cooperative launch failed: %s (grid %d)\n", hipGetErrorString(e), grid_blocks);
#else
    for (int ph = 0; ph < NPHASE; ++ph) {
        p.ph_lo = ph; p.ph_hi = ph + 1;
        hipLaunchKernelGGL(fwd_kernel, dim3(grid_blocks), dim3(NTHR), LDS_BYTES, stream, p);
    }
#endif
}
```

```cpp
#include <hip/hip_runtime.h>
#include <hip/hip_cooperative_groups.h>
#include <cstdio>
#include <cstdint>
namespace cg = cooperative_groups;

#ifndef MULTI_LAUNCH
#define MULTI_LAUNCH 0
#endif

#define DI __device__ __forceinline__
typedef unsigned short bf16_t;
typedef __bf16 bf16v2 __attribute__((ext_vector_type(2)));
typedef float f32x2 __attribute__((ext_vector_type(2)));
typedef short s16x8 __attribute__((ext_vector_type(8)));
typedef short s16x4 __attribute__((ext_vector_type(4)));
typedef float f32x16 __attribute__((ext_vector_type(16)));
typedef float f32x4 __attribute__((ext_vector_type(4)));
typedef unsigned u32x4 __attribute__((ext_vector_type(4)));
typedef unsigned u32x2 __attribute__((ext_vector_type(2)));

constexpr int DM = 1024, NB = 4, SEQ = 8192, CTXL = 256, TT = SEQ + CTXL  , RT = NB * TT  ;
constexpr int DFF = 2816;
constexpr float EPS = 1e-5f;
constexpr float ALPHA = 1.41421356237309515f;
constexpr int NTHR = 256;
constexpr int LDS_BYTES = 77824;

constexpr size_t al256(size_t x) { return (x + 255) & ~(size_t)255; }
constexpr size_t W_ABIN = 0;
constexpr size_t W_UQ = W_ABIN + al256((size_t)2816 * 1024 * 2);
constexpr size_t W_UKV = W_UQ + al256((size_t)768 * 384 * 2);
constexpr size_t W_ABOUT = W_UKV + al256((size_t)1024 * 256 * 2);
constexpr size_t W_FFIN = W_ABOUT + al256((size_t)1024 * 1024 * 2);
constexpr size_t W_FFOUT = W_FFIN + al256((size_t)2 * 5632 * 1024 * 2);
constexpr size_t W_MIN = W_FFOUT + al256((size_t)2 * 1024 * 2816 * 2);
constexpr size_t W_MOUT = W_MIN + al256((size_t)3200 * 1024 * 2);
constexpr size_t O_MODV = W_MOUT + al256((size_t)1024 * 1024 * 2);
constexpr size_t O_TABR = O_MODV + al256((size_t)2 * 5 * 6144 * 4);
constexpr size_t O_TABM = O_TABR + al256((size_t)128 * 32 * 2 * 4);
constexpr size_t O_XCTX = O_TABM + al256((size_t)128 * 8 * 2 * 4);
constexpr size_t O_SSQ = O_XCTX + al256((size_t)1024 * 1024 * 4);
constexpr size_t O_STATS = O_SSQ + al256((size_t)RT * 8 * 4);
constexpr size_t O_H = O_STATS + al256((size_t)3 * RT * 8 * 4);
constexpr size_t O_BAR = O_H + al256((size_t)RT * 1024 * 2);
constexpr size_t O_ARENA = O_BAR + al256((size_t)16384);
constexpr size_t A0_RQ = O_ARENA;
constexpr size_t A0_RK = A0_RQ + al256((size_t)RT * 512 * 2);
constexpr size_t A0_RVT = A0_RK + al256((size_t)RT * 512 * 2);
constexpr size_t A0_RG = A0_RVT + al256((size_t)RT * 512 * 2);
constexpr size_t A0_QB = A0_RG + al256((size_t)RT * 512 * 2);
constexpr size_t A0_KB = A0_QB + al256((size_t)NB * 8 * TT * 96 * 2);
constexpr size_t A0_VT = A0_KB + al256((size_t)NB * 8 * TT * 96 * 2);
constexpr size_t A0_RUS = A0_VT + al256((size_t)NB * 8 * 64 * TT * 2);
constexpr size_t A0_CQ = A0_RUS + al256((size_t)NB * 4 * 2 * 66 * 128 * 128 * 2);
constexpr size_t A0_CKV = A0_CQ + al256((size_t)RT * 384 * 2);
constexpr size_t A0_END = A0_CKV + al256((size_t)RT * 256 * 2);
constexpr size_t O_PART = O_ARENA + (size_t)200 * 1024 * 1024;
constexpr size_t O_ACT = O_ARENA;
constexpr size_t A1_QKPRE = O_ARENA;
constexpr size_t A1_VT = A1_QKPRE + al256((size_t)RT * 1024 * 2);
constexpr size_t A1_OG = A1_VT + al256((size_t)RT * 1024 * 2);
constexpr size_t A1_G = A1_OG + al256((size_t)RT * 1024 * 2);
constexpr size_t A1_U = A1_G + al256((size_t)RT * 32 * 4);
constexpr size_t A1_N = A1_U + al256((size_t)NB * 8 * 2 * 132 * 128 * 64 * 2);
constexpr size_t A1_SC = A1_N + al256((size_t)NB * 8 * 2 * 132 * 64 * 4);
constexpr size_t A1_HALO = A1_SC + al256((size_t)NB * 8 * 2 * 132 * 4 * 4);
constexpr size_t A1_END = A1_HALO + al256((size_t)(RT / 128) * 4 * 1024 * 4);
constexpr size_t WS_NEED = (A0_END > A1_END ? A0_END : A1_END);
static_assert(WS_NEED <= (size_t)536870912, "workspace over 512 MiB");
static_assert(O_ACT + (size_t)RT * 2816 * 2 <= WS_NEED, "act");

struct Params {
    const float *x, *c, *ctx, *c_ctx, *mod_w, *mod_b, *ln_g, *ln_b, *ffn_w_in, *ffn_w_out, *ab_w_in, *q_norm, *w_uq, *kv_norm, *w_ukv,
        *ret_ld, *ab_w_out, *m_w_in, *m_conv_w, *m_conv_b, *m_gate_b, *m_norm_g, *m_w_out;
    float* out; char* ws; int ph_lo, ph_hi;
};

DI unsigned pk(float lo, float hi) { f32x2 v = {lo, hi}; return __builtin_bit_cast(unsigned, __builtin_convertvector(v, bf16v2)); }
DI float bflo(unsigned u) { return __uint_as_float(u << 16); }
DI float bfhi(unsigned u) { return __uint_as_float(u & 0xffff0000u); }
DI bf16_t f2bf(float x) { return (bf16_t)(pk(x, 0.f) & 0xffffu); }
DI float bf2f(bf16_t x) { return __uint_as_float(((unsigned)x) << 16); }
DI int crow(int reg, int h2) { return (reg & 3) + 8 * (reg >> 2) + 4 * h2; }
DI float siluf(float x) { return x * __builtin_amdgcn_rcpf(1.f + __expf(-x)); }
DI float sigmf(float x) { return __builtin_amdgcn_rcpf(1.f + __expf(-x)); }
#define MFMA32(a, b, c) __builtin_amdgcn_mfma_f32_32x32x16_bf16((a), (b), (c), 0, 0, 0)
DI s16x8 pack8(float a0, float a1, float a2, float a3, float a4, float a5, float a6, float a7) {
    u32x4 t = {pk(a0, a1), pk(a2, a3), pk(a4, a5), pk(a6, a7)}; return __builtin_bit_cast(s16x8, t);
}
DI s16x8 cat4(s16x4 lo, s16x4 hi) { return __builtin_shufflevector(lo, hi, 0, 1, 2, 3, 4, 5, 6, 7); }
DI void zero16(f32x16& v) {
#pragma unroll
    for (int i = 0; i < 16; ++i) v[i] = 0.f;
}
DI float* xrow(const Params& p, int g) {
    const int b = g / TT, t = g - b * TT;
    return t < CTXL ? (float*)(p.ws + O_XCTX) + (size_t)(b * CTXL + t) * DM : p.out + (size_t)(b * SEQ + t - CTXL) * DM;
}
DI const float* xrow_in(const Params& p, int g) {
    const int b = g / TT, t = g - b * TT;
    return t < CTXL ? p.ctx + (size_t)(b * CTXL + t) * DM : p.x + (size_t)(b * SEQ + t - CTXL) * DM;
}
DI int modidx(int g) { const int b = g / TT, t = g - b * TT; return t < CTXL ? 4 : b; }

template <class Map>
DI void wconv(const float* src, int K, int Nsrc, int Ndst, bf16_t* dst, const float* rowscale, Map map, int gtid, int gthreads) {
    const int k8n = K >> 3; const long items = (long)Ndst * k8n;
    for (long it = gtid; it < items; it += gthreads) {
        const int n = (int)(it % Ndst), k8 = (int)(it / Ndst);
        const int sn = map(n);
        float v[8];
#pragma unroll
        for (int j = 0; j < 8; ++j) {
            const int k = k8 * 8 + j;
            float x = sn >= 0 ? src[(size_t)k * Nsrc + sn] : 0.f;
            if (rowscale) x *= rowscale[k];
            v[j] = x;
        }
        u32x4 o = {pk(v[0], v[1]), pk(v[2], v[3]), pk(v[4], v[5]), pk(v[6], v[7])};
        *(u32x4*)(dst + (size_t)n * K + k8 * 8) = o;
    }
}
struct MapId { int nsrc; DI int operator()(int n) const { return n < nsrc ? n : -1; } };
struct MapAbIn { DI int operator()(int n) const { return n < 640 ? n : (n < 2688 ? n + 32 : (n < 2720 ? n - 2688 + 640 : -1)); } };
struct MapUq { DI int operator()(int n) const { if (n < 512) return (n >> 6) * 96 + (n & 63); const int m = n - 512; return (m >> 5) * 96 + 64 + (m & 31); } };
struct MapFfIn { DI int operator()(int n) const { const int t = n >> 7, j = n & 127; return j < 64 ? t * 64 + j : 2816 + t * 64 + (j - 64); } };

DI void sincos_acc(float theta, float& c, float& s) {
    const double th = (double)theta;
    const double kq = __builtin_rint(th * 0.63661977236758134308);
    const double r = (th - kq * 1.57079632679489655800) - kq * 6.123233995736766e-17;
    const double r2 = r * r;
    const double sp = r * (1.0 + r2 * (-1.0 / 6 + r2 * (1.0 / 120 + r2 * (-1.0 / 5040 + r2 * (1.0 / 362880 + r2 * (-1.0 / 39916800 + r2 * (1.0 / 6227020800.0)))))));
    const double cp = 1.0 + r2 * (-0.5 + r2 * (1.0 / 24 + r2 * (-1.0 / 720 + r2 * (1.0 / 40320 + r2 * (-1.0 / 3628800 + r2 * (1.0 / 479001600.0 + r2 * (-1.0 / 87178291200.0)))))));
    const int q = ((int)kq) & 3;
    const double cc = (q == 0) ? cp : (q == 1) ? -sp : (q == 2) ? -cp : sp;
    const double ss = (q == 0) ? sp : (q == 1) ? cp : (q == 2) ? -sp : -cp;
    c = (float)cc; s = (float)ss;
}

DI void phase_prologue(const Params& p, char* lds, int bid, int nb) {
    const int tid = threadIdx.x; const int gtid = bid * NTHR + tid, gthreads = nb * NTHR;
    char* ws = p.ws;
    wconv(p.ab_w_in, 1024, 2720, 2816, (bf16_t*)(ws + W_ABIN), nullptr, MapAbIn{}, gtid, gthreads);
    wconv(p.w_uq, 384, 768, 768, (bf16_t*)(ws + W_UQ), p.q_norm, MapUq{}, gtid, gthreads);
    wconv(p.w_ukv, 256, 1024, 1024, (bf16_t*)(ws + W_UKV), p.kv_norm, MapId{1024}, gtid, gthreads);
    wconv(p.ab_w_out, 1024, 1024, 1024, (bf16_t*)(ws + W_ABOUT), nullptr, MapId{1024}, gtid, gthreads);
    for (int l = 0; l < 2; ++l) {
        wconv(p.ffn_w_in + (size_t)l * 1024 * 5632, 1024, 5632, 5632, (bf16_t*)(ws + W_FFIN) + (size_t)l * 5632 * 1024, nullptr, MapFfIn{}, gtid, gthreads);
        wconv(p.ffn_w_out + (size_t)l * 2816 * 1024, 2816, 1024, 1024, (bf16_t*)(ws + W_FFOUT) + (size_t)l * 1024 * 2816, nullptr, MapId{1024}, gtid, gthreads);
    }
    wconv(p.m_w_in, 1024, 3104, 3200, (bf16_t*)(ws + W_MIN), nullptr, MapId{3104}, gtid, gthreads);
    wconv(p.m_w_out, 1024, 1024, 1024, (bf16_t*)(ws + W_MOUT), nullptr, MapId{1024}, gtid, gthreads);
    if (gtid < 128 * 32) {
        const int pos = gtid >> 5, i = gtid & 31;
        const float inv = exp2f(-(float)i * (13.28771237954945f / 32.f));
        float c, s; sincos_acc((float)pos * inv, c, s);
        float* t = (float*)(ws + O_TABR) + (size_t)gtid * 2; t[0] = c; t[1] = s;
    } else if (gtid < 128 * 32 + 128 * 8) {
        const int j = gtid - 128 * 32; const int pos = j >> 3, i = j & 7;
        const float inv = exp2f(-(float)i * (13.28771237954945f / 8.f));
        float c, s; sincos_acc((float)pos * inv, c, s);
        float* t = (float*)(ws + O_TABM) + (size_t)j * 2; t[0] = c; t[1] = s;
    }
    float* sc = (float*)lds;
    float* red = sc + 5 * 1024;
    bool have = false;
    for (int u = bid; u < 2 * 96; u += nb) {
        if (!have) {
            for (int i = tid; i < 5 * 1024; i += NTHR) { const float v = i < 4096 ? p.c[i] : p.c_ctx[i - 4096]; sc[i] = siluf(v); }
            __syncthreads(); have = true;
        }
        const int l = u / 96, nblk = u - l * 96; const int col = nblk * 64 + (tid & 63), kq = tid >> 6;
        const float* w = p.mod_w + (size_t)l * 1024 * 6144 + col;
        float a[5] = {0.f, 0.f, 0.f, 0.f, 0.f};
        for (int k = kq * 256; k < kq * 256 + 256; ++k) {
            const float wv = w[(size_t)k * 6144];
#pragma unroll
            for (int m = 0; m < 5; ++m) a[m] += sc[m * 1024 + k] * wv;
        }
#pragma unroll
        for (int m = 0; m < 5; ++m) red[(kq * 5 + m) * 64 + (tid & 63)] = a[m];
        __syncthreads();
        if (tid < 64) {
            const float bias = p.mod_b[l * 6144 + col];
#pragma unroll
            for (int m = 0; m < 5; ++m) {
                const float s = red[(0 * 5 + m) * 64 + tid] + red[(1 * 5 + m) * 64 + tid] + red[(2 * 5 + m) * 64 + tid] + red[(3 * 5 + m) * 64 + tid];
                ((float*)(ws + O_MODV))[(size_t)(l * 5 + m) * 6144 + col] = s + bias;
            }
        }
        __syncthreads();
    }
}

DI void phase_modulate0(const Params& p, int bid, int nb) {
    const int tid = threadIdx.x; const long gtid = (long)bid * NTHR + tid, gthreads = (long)nb * NTHR;
    const float* modv = (const float*)(p.ws + O_MODV);
    bf16_t* H = (bf16_t*)(p.ws + O_H);
    for (long it = gtid; it < (long)RT * 128; it += gthreads) {
        const int g = (int)(it >> 7), c8 = (int)(it & 127) * 8;
        const float* xr = xrow_in(p, g) + c8; const int mi = modidx(g);
        const float* sh = modv + (size_t)(0 * 5 + mi) * 6144 + 0 * 1024 + c8; const float* sc = sh + 1024;
        const f32x4 a = *(const f32x4*)xr, b = *(const f32x4*)(xr + 4);
        const f32x4 s0 = *(const f32x4*)sh, s1 = *(const f32x4*)(sh + 4), c0 = *(const f32x4*)sc, c1 = *(const f32x4*)(sc + 4);
        const f32x4 y0 = a * (1.f + c0) + s0, y1 = b * (1.f + c1) + s1;
        u32x4 o = {pk(y0[0], y0[1]), pk(y0[2], y0[3]), pk(y1[0], y1[1]), pk(y1[2], y1[3])};
        *(u32x4*)(H + (size_t)g * 1024 + c8) = o;
    }
}

struct GemmArgs { const bf16_t* A; int lda; const bf16_t* Bt; int ldb; int K; int ntm; int ntn; int latonly; int ksplit; };
constexpr int GST = 72;
constexpr int CST = 136;
constexpr int EPI_AUX = 69632;

template <class Epi>
DI void gemm_phase(const GemmArgs& ga, const Epi& epi, char* lds, int bid, int nb) {
    constexpr int KS = 40;
    bf16_t* As = (bf16_t*)lds;
    bf16_t* Bs = As + 2 * 256 * KS;
    float* Cs = (float*)lds;
    const int tid = threadIdx.x, lane = tid & 63, w = tid >> 6, wm = w >> 1, wn = w & 1, l31 = lane & 31, h2 = lane >> 5;
    const int ks_ = ga.ksplit > 1 ? ga.ksplit : 1; const int klen = ga.K / ks_;
    const int ntnv = ga.ntn * ks_;
    const int ntiles = ga.ntm * ntnv, nk = klen >> 5;
    const int xcd = bid & 7, jx = bid >> 3, per = nb >> 3;
    const int nchunk = (ntiles + 63) >> 6;
    const int spc = (64 + per - 1) / per;
    const int lr = tid >> 2, lc = (tid & 3) * 8;
    for (int it = 0;; ++it) {
        const int q = xcd + 8 * (it / spc), tslot = jx + per * (it % spc);
        if (q >= nchunk) break;
        const int tile = q * 64 + tslot;
        if (tslot >= 64 || tile >= ntiles) continue;
        const int grp = tile / (4 * ntnv), rem = tile - grp * 4 * ntnv;
        const int ntv = rem >> 2, mt = grp * 4 + (rem & 3);
        const int part = ntv / ga.ntn, nt = ntv - part * ga.ntn;
        const int g0 = ga.latonly == 1 ? ((mt >> 5) * TT + CTXL + (mt & 31) * 256) : (ga.latonly == 2 ? mt * TT : mt * 256);
        const bf16_t* Ag = ga.A + (size_t)(g0 + lr) * ga.lda + lc + part * klen;
        const bf16_t* Bg = ga.Bt + (size_t)(nt * 128 + lr) * ga.ldb + lc + part * klen;
        const size_t a64 = (size_t)64 * ga.lda, b64 = (size_t)64 * ga.ldb;
        f32x16 acc[4][2];
#pragma unroll
        for (int i = 0; i < 4; ++i)
#pragma unroll
            for (int j = 0; j < 2; ++j) zero16(acc[i][j]);
        u32x4 ra0[4], rb0[2], ra1[4], rb1[2];
#define G_LOAD(RA, RB, K0) { _Pragma("unroll") for (int i = 0; i < 4; ++i) RA[i] = *(const u32x4*)(Ag + i * a64 + (K0)); \
                             _Pragma("unroll") for (int i = 0; i < 2; ++i) RB[i] = *(const u32x4*)(Bg + i * b64 + (K0)); }
#define G_STORE(RA, RB, ST) { bf16_t* Aw = As + (ST) * 256 * KS; bf16_t* Bw = Bs + (ST) * 128 * KS; \
                             _Pragma("unroll") for (int i = 0; i < 4; ++i) *(u32x4*)(Aw + (lr + 64 * i) * KS + lc) = RA[i]; \
                             _Pragma("unroll") for (int i = 0; i < 2; ++i) *(u32x4*)(Bw + (lr + 64 * i) * KS + lc) = RB[i]; }
#define G_COMPUTE_STORE(ST, RA, RB, LA, LB, LK) { const bf16_t* Ac = As + (ST) * 256 * KS + (wm * 128 + l31) * KS + h2 * 8; \
                        const bf16_t* Bc = Bs + (ST) * 128 * KS + (wn * 64 + l31) * KS + h2 * 8; \
                        s16x8 fa0[4], fb0[2], fa1[4], fb1[2]; \
                        _Pragma("unroll") for (int mi = 0; mi < 4; ++mi) fa0[mi] = *(const s16x8*)(Ac + mi * 32 * KS); \
                        fb0[0] = *(const s16x8*)(Bc); fb0[1] = *(const s16x8*)(Bc + 32 * KS); \
                        G_LOAD(LA, LB, LK) \
                        _Pragma("unroll") for (int mi = 0; mi < 4; ++mi) fa1[mi] = *(const s16x8*)(Ac + mi * 32 * KS + 16); \
                        fb1[0] = *(const s16x8*)(Bc + 16); fb1[1] = *(const s16x8*)(Bc + 32 * KS + 16); \
                        _Pragma("unroll") for (int mi = 0; mi < 4; ++mi) { acc[mi][0] = MFMA32(fa0[mi], fb0[0], acc[mi][0]); acc[mi][1] = MFMA32(fa0[mi], fb0[1], acc[mi][1]); } \
                        _Pragma("unroll") for (int mi = 0; mi < 4; ++mi) { acc[mi][0] = MFMA32(fa1[mi], fb1[0], acc[mi][0]); acc[mi][1] = MFMA32(fa1[mi], fb1[1], acc[mi][1]); } \
                        G_STORE(RA, RB, (ST) ^ 1) \
                        __builtin_amdgcn_sched_group_barrier(0x100, 6, 0); \
                        __builtin_amdgcn_sched_group_barrier(0x008, 2, 0); __builtin_amdgcn_sched_group_barrier(0x100, 2, 0); __builtin_amdgcn_sched_group_barrier(0x020, 2, 0); \
                        __builtin_amdgcn_sched_group_barrier(0x008, 2, 0); __builtin_amdgcn_sched_group_barrier(0x100, 2, 0); __builtin_amdgcn_sched_group_barrier(0x020, 2, 0); \
                        __builtin_amdgcn_sched_group_barrier(0x008, 2, 0); __builtin_amdgcn_sched_group_barrier(0x100, 1, 0); __builtin_amdgcn_sched_group_barrier(0x020, 2, 0); \
                        __builtin_amdgcn_sched_group_barrier(0x008, 2, 0); __builtin_amdgcn_sched_group_barrier(0x100, 1, 0); \
                        __builtin_amdgcn_sched_group_barrier(0x008, 2, 0); __builtin_amdgcn_sched_group_barrier(0x200, 2, 0); \
                        __builtin_amdgcn_sched_group_barrier(0x008, 2, 0); __builtin_amdgcn_sched_group_barrier(0x200, 2, 0); \
                        __builtin_amdgcn_sched_group_barrier(0x008, 2, 0); __builtin_amdgcn_sched_group_barrier(0x200, 2, 0); \
                        __builtin_amdgcn_sched_group_barrier(0x008, 2, 0); \
                        __builtin_amdgcn_sched_barrier(0); }
        G_LOAD(ra0, rb0, 0)
        G_STORE(ra0, rb0, 0)
        G_LOAD(ra0, rb0, 32)
        __syncthreads();
        for (int kt = 0; kt < nk; kt += 2) {
            { const int kk = (kt + 2 < nk ? kt + 2 : nk - 1) * 32;
              G_COMPUTE_STORE(0, ra0, rb0, ra1, rb1, kk) }
            __syncthreads();
            { const int kk = (kt + 3 < nk ? kt + 3 : nk - 1) * 32;
              G_COMPUTE_STORE(1, ra1, rb1, ra0, rb0, kk) }
            __syncthreads();
        }
#undef G_LOAD
#undef G_STORE
#undef G_COMPUTE_STORE
#pragma unroll
        for (int hh = 0; hh < 2; ++hh) {
            if (wm == hh) {
#pragma unroll
                for (int mi = 0; mi < 4; ++mi)
#pragma unroll
                    for (int ni = 0; ni < 2; ++ni)
#pragma unroll
                        for (int r = 0; r < 16; ++r) Cs[(mi * 32 + crow(r, h2)) * CST + wn * 64 + ni * 32 + l31] = acc[mi][ni][r];
            }
            __syncthreads();
            epi(Cs, lds, g0 + hh * 128, nt + ga.ntn * part);
            __syncthreads();
        }
    }
}

template <int NCOLS>
DI void twrite(const float* Cs, int c_lo, bf16_t* dst, size_t ld, const float* rowscale) {
    constexpr int TPC = 256 / NCOLS, RPT = 128 / TPC;
    int tid = threadIdx.x; asm volatile("" : "+v"(tid)); const int c = tid % NCOLS, part = tid / NCOLS;
    const float* src = Cs + c_lo + c;
    bf16_t* d = dst + (size_t)c * ld + part * RPT;
#pragma unroll 2
    for (int j = 0; j < RPT / 8; ++j) {
        float v[8];
#pragma unroll
        for (int e = 0; e < 8; ++e) { const int row = part * RPT + j * 8 + e; float x = src[row * CST]; if (rowscale) x *= rowscale[row]; v[e] = x; }
        u32x4 o = {pk(v[0], v[1]), pk(v[2], v[3]), pk(v[4], v[5]), pk(v[6], v[7])};
        *(u32x4*)(d + j * 8) = o;
    }
}

DI f32x4 rope4(f32x4 v, f32x4 pv, const float* tab, bool second) {
    const f32x4 t0 = *(const f32x4*)tab, t1 = *(const f32x4*)(tab + 4);
    const f32x4 cs = {t0[0], t0[2], t1[0], t1[2]}, sn = {t0[1], t0[3], t1[1], t1[3]};
    return second ? pv * sn + v * cs : v * cs - pv * sn;
}

struct EpiAbIn {
    Params p;
    DI void operator()(const float* Cs, char* lds, int g0, int nt) const {
        int tid = threadIdx.x; asm volatile("" : "+v"(tid)); const int lane = tid & 63, w = tid >> 6, l31 = lane & 31, h2 = lane >> 5;
        const int b = g0 / TT, t0 = g0 - b * TT; const bool lat = t0 >= CTXL; const int c = 4 * l31;
        char* ws = p.ws;
        if (nt < 5) {
            bf16_t* dst = nt < 3 ? (bf16_t*)(ws + A0_CQ) + (size_t)g0 * 384 + nt * 128 : (bf16_t*)(ws + A0_CKV) + (size_t)g0 * 256 + (nt - 3) * 128;
            const int ld = nt < 3 ? 384 : 256;
            float* ssq = (float*)(ws + O_SSQ);
#pragma unroll 1
            for (int i = 0; i < 16; ++i) {
                const int row = w * 32 + 2 * i + h2;
                const f32x4 v = *(const f32x4*)(Cs + row * CST + c);
                float ss = v[0] * v[0] + v[1] * v[1] + v[2] * v[2] + v[3] * v[3];
                ss += __shfl_xor(ss, 1); ss += __shfl_xor(ss, 2); ss += __shfl_xor(ss, 4); ss += __shfl_xor(ss, 8); ss += __shfl_xor(ss, 16);
                u32x2 o = {pk(v[0], v[1]), pk(v[2], v[3])};
                *(u32x2*)(dst + (size_t)row * ld + c) = o;
                if (l31 == 0) ssq[(size_t)(g0 + row) * 8 + nt] = ss;
            }
        } else if (nt < 13) {
            const bool isk = nt >= 9; const int hh = (nt - 5) & 3;
            bf16_t* dst = (bf16_t*)(ws + (isk ? A0_RK : A0_RQ)) + (size_t)g0 * 512 + hh * 128;
            const float scl = isk ? 0.08838834764831845f : 1.f;
            const float* tab = (const float*)(ws + O_TABR);
#pragma unroll 1
            for (int i = 0; i < 16; ++i) {
                const int row = w * 32 + 2 * i + h2;
                f32x4 v = *(const f32x4*)(Cs + row * CST + c);
                if (lat) {
                    const f32x4 pv = *(const f32x4*)(Cs + row * CST + (c ^ 32));
                    const int s = t0 + row - CTXL; const int pos = c < 64 ? (s >> 6) : (s & 63);
                    v = rope4(v, pv, tab + (size_t)(pos * 32 + (c & 31)) * 2, (c & 32) != 0);
                }
                v = v * scl;
                u32x2 o = {pk(v[0], v[1]), pk(v[2], v[3])};
                *(u32x2*)(dst + (size_t)row * 512 + c) = o;
            }
        } else if (nt < 17) {
            const int hh = nt - 13;
            twrite<128>(Cs, 0, (bf16_t*)(ws + A0_RVT) + ((size_t)(b * 4 + hh) * 128) * TT + t0, TT, nullptr);
        } else if (nt < 21) {
            bf16_t* dst = (bf16_t*)(ws + A0_RG) + (size_t)g0 * 512 + (nt - 17) * 128;
#pragma unroll 1
            for (int i = 0; i < 16; ++i) {
                const int row = w * 32 + 2 * i + h2;
                const f32x4 v = *(const f32x4*)(Cs + row * CST + c);
                u32x2 o = {pk(v[0], v[1]), pk(v[2], v[3])};
                *(u32x2*)(dst + (size_t)row * 512 + c) = o;
            }
        } else {
            const float* tab = (const float*)(ws + O_TABM);
            bf16_t* kb = (bf16_t*)(ws + A0_KB);
            if (l31 < 8) {
#pragma unroll 1
                for (int i = 0; i < 16; ++i) {
                    const int row = w * 32 + 2 * i + h2;
                    f32x4 v = *(const f32x4*)(Cs + row * CST + c);
                    if (lat) {
                        const f32x4 pv = *(const f32x4*)(Cs + row * CST + (c ^ 8));
                        const int s = t0 + row - CTXL; const int pos = c < 16 ? (s >> 6) : (s & 63);
                        v = rope4(v, pv, tab + (size_t)(pos * 8 + (c & 7)) * 2, (c & 8) != 0);
                    }
                    u32x2 o = {pk(v[0], v[1]), pk(v[2], v[3])};
#pragma unroll
                    for (int h = 0; h < 8; ++h) *(u32x2*)(kb + ((size_t)(b * 8 + h) * TT + t0 + row) * 96 + 64 + c) = o;
                }
            }
        }
    }
};

struct EpiUq {
    Params p;
    DI void operator()(const float* Cs, char* lds, int g0, int nt) const {
        int tid = threadIdx.x; asm volatile("" : "+v"(tid)); const int lane = tid & 63, w = tid >> 6, l31 = lane & 31, h2 = lane >> 5;
        const int b = g0 / TT, t0 = g0 - b * TT; const bool lat = t0 >= CTXL; const int c = 4 * l31;
        char* ws = p.ws;
        const float* ssq = (const float*)(ws + O_SSQ);
        bf16_t* qb = (bf16_t*)(ws + A0_QB);
        const float* tab = (const float*)(ws + O_TABM);
        const float qscale = 0.10206207261596575f * 1.4426950408889634f;
#pragma unroll 1
        for (int i = 0; i < 16; ++i) {
            const int row = w * 32 + 2 * i + h2; const int g = g0 + row;
            const float rs = rsqrtf((ssq[(size_t)g * 8] + ssq[(size_t)g * 8 + 1] + ssq[(size_t)g * 8 + 2]) * (1.f / 384.f) + EPS) * qscale;
            f32x4 v = *(const f32x4*)(Cs + row * CST + c);
            int head, j;
            if (nt < 4) { head = nt * 2 + (c >> 6); j = c & 63; }
            else {
                head = (nt - 4) * 4 + (c >> 5); const int jj = c & 31; j = 64 + jj;
                if (lat) {
                    const f32x4 pv = *(const f32x4*)(Cs + row * CST + (c ^ 8));
                    const int s = t0 + row - CTXL; const int pos = jj < 16 ? (s >> 6) : (s & 63);
                    v = rope4(v, pv, tab + (size_t)(pos * 8 + (jj & 7)) * 2, (jj & 8) != 0);
                }
            }
            v = v * rs;
            u32x2 o = {pk(v[0], v[1]), pk(v[2], v[3])};
            *(u32x2*)(qb + ((size_t)(b * 8 + head) * TT + t0 + row) * 96 + j) = o;
        }
    }
};

struct EpiUkv {
    Params p;
    DI void operator()(const float* Cs, char* lds, int g0, int nt) const {
        int tid = threadIdx.x; asm volatile("" : "+v"(tid)); const int lane = tid & 63, w = tid >> 6, l31 = lane & 31, h2 = lane >> 5;
        const int b = g0 / TT, t0 = g0 - b * TT; const int c = 4 * l31;
        char* ws = p.ws;
        const float* ssq = (const float*)(ws + O_SSQ);
        float* rsl = (float*)(lds + EPI_AUX);
        if (tid < 128) { const int g = g0 + tid; rsl[tid] = rsqrtf((ssq[(size_t)g * 8 + 3] + ssq[(size_t)g * 8 + 4]) * (1.f / 256.f) + EPS); }
        __syncthreads();
        bf16_t* kb = (bf16_t*)(ws + A0_KB);
        if (l31 < 16) {
#pragma unroll 1
            for (int i = 0; i < 16; ++i) {
                const int row = w * 32 + 2 * i + h2;
                f32x4 v = *(const f32x4*)(Cs + row * CST + c); v = v * rsl[row];
                u32x2 o = {pk(v[0], v[1]), pk(v[2], v[3])};
                *(u32x2*)(kb + ((size_t)(b * 8 + nt) * TT + t0 + row) * 96 + c) = o;
            }
        }
        twrite<64>(Cs, 64, (bf16_t*)(ws + A0_VT) + ((size_t)(b * 8 + nt) * 64) * TT + t0, TT, rsl);
    }
};

struct EpiResid {
    Params p; int layer, gate_chunk, from_input, partial, lazy, lnl, lnw;
    DI void operator()(const float* Cs, char* lds, int g0, int ntv) const {
        int tid = threadIdx.x; asm volatile("" : "+v"(tid)); const int lane = tid & 63, w = tid >> 6, l31 = lane & 31, h2 = lane >> 5;
        const int c = 4 * l31;
        if (partial) {
            const int part = ntv >> 3, nt = ntv & 7;
            const int b = g0 / TT, t0 = g0 - b * TT;
            float* dst = (float*)(p.ws + O_PART) + ((size_t)part * 1024 + b * CTXL + t0) * DM + nt * 128 + c;
#pragma unroll 4
            for (int i = 0; i < 16; ++i) { const int row = w * 32 + 2 * i + h2; *(f32x4*)(dst + (size_t)row * DM) = *(const f32x4*)(Cs + row * CST + c); }
            return;
        }
        const int nt = ntv; const int mi = modidx(g0);
        const float* gate = (const float*)(p.ws + O_MODV) + (size_t)(layer * 5 + mi) * 6144 + gate_chunk * 1024 + nt * 128 + c;
        const f32x4 gv = *(const f32x4*)gate;
        f32x4 lgv = {1.f, 1.f, 1.f, 1.f}, lbv = {0.f, 0.f, 0.f, 0.f};
        const float* st = (const float*)(p.ws + O_STATS) + (size_t)(lazy > 0 ? lazy - 1 : 0) * RT * 8;
        if (lazy > 0) { lgv = *(const f32x4*)(p.ln_g + (size_t)(lnl * 2 + lnw) * 1024 + nt * 128 + c); lbv = *(const f32x4*)(p.ln_b + (size_t)(lnl * 2 + lnw) * 1024 + nt * 128 + c); }
#pragma unroll 4
        for (int i = 0; i < 16; ++i) {
            const int row = w * 32 + 2 * i + h2; const int g = g0 + row;
            const f32x4 v = *(const f32x4*)(Cs + row * CST + c);
            float* xd = xrow(p, g) + nt * 128 + c;
            const float* xs = from_input ? xrow_in(p, g) + nt * 128 + c : xd;
            f32x4 xv = *(const f32x4*)xs;
            if (lazy > 0) { const float mu = __hip_atomic_load(st + (size_t)g * 8, __ATOMIC_RELAXED, __HIP_MEMORY_SCOPE_AGENT), rs = __hip_atomic_load(st + (size_t)g * 8 + 1, __ATOMIC_RELAXED, __HIP_MEMORY_SCOPE_AGENT); xv = (xv - mu) * rs * lgv + lbv; }
            *(f32x4*)xd = xv * ALPHA + gv * v;
        }
    }
};

struct EpiFfIn {
    Params p;
    DI void operator()(const float* Cs, char* lds, int g0, int nt) const {
        int tid = threadIdx.x; asm volatile("" : "+v"(tid)); const int lane = tid & 63, w = tid >> 6;
        const int c = 4 * (lane & 15);
        bf16_t* act = (bf16_t*)(p.ws + O_ACT);
#pragma unroll 4
        for (int i = 0; i < 8; ++i) {
            const int row = w * 32 + i * 4 + (lane >> 4);
            const f32x4 up = *(const f32x4*)(Cs + row * CST + c), gt = *(const f32x4*)(Cs + row * CST + 64 + c);
            u32x2 o = {pk(siluf(gt[0]) * up[0], siluf(gt[1]) * up[1]), pk(siluf(gt[2]) * up[2], siluf(gt[3]) * up[3])};
            *(u32x2*)(act + (size_t)(g0 + row) * DFF + nt * 64 + c) = o;
        }
    }
};

DI float logsigmoidf(float x) { return fminf(x, 0.f) - log1pf(__expf(-fabsf(x))); }

struct EpiMIn {
    static constexpr bool PREFETCH = false;
    Params p;
    DI void operator()(const float* Cs, char* lds, int g0, int nt) const {
        int tid = threadIdx.x; asm volatile("" : "+v"(tid)); const int lane = tid & 63, w = tid >> 6, l31 = lane & 31, h2 = lane >> 5;
        const int b = g0 / TT, t0 = g0 - b * TT; const int c = 4 * l31;
        char* ws = p.ws;
        if (nt < 8) {
            const int ch = nt * 128 + c;
            bf16_t* dst = (bf16_t*)(ws + A1_QKPRE) + (size_t)g0 * 1024 + ch;
            float* halo = (float*)(ws + A1_HALO) + (size_t)(g0 >> 7) * 4 * 1024 + ch;
            const f32x4 w0 = *(const f32x4*)(p.m_conv_w + ch), w1 = *(const f32x4*)(p.m_conv_w + 1024 + ch), w2 = *(const f32x4*)(p.m_conv_w + 2048 + ch), bb = *(const f32x4*)(p.m_conv_b + ch);
            const float scl = nt >= 4 ? 0.125f : 1.f;
#pragma unroll 1
            for (int i = 0; i < 16; ++i) {
                const int row = w * 32 + 2 * i + h2;
                const f32x4 x0 = *(const f32x4*)(Cs + row * CST + c);
                if (row == 0 || row == 1 || row == 126 || row == 127) *(f32x4*)(halo + (size_t)(row < 2 ? row : row - 124) * 1024) = x0;
                if (row >= 1 && row <= 126) {
                    const f32x4 xm = *(const f32x4*)(Cs + (row - 1) * CST + c), xp = *(const f32x4*)(Cs + (row + 1) * CST + c);
                    const f32x4 a = xm * w0 + x0 * w1 + xp * w2 + bb;
                    u32x2 o = {pk(siluf(a[0]) * scl, siluf(a[1]) * scl), pk(siluf(a[2]) * scl, siluf(a[3]) * scl)};
                    *(u32x2*)(dst + (size_t)row * 1024) = o;
                }
            }
        } else if (nt >= 16 && nt < 24) {
            bf16_t* dst = (bf16_t*)(ws + A1_OG) + (size_t)g0 * 1024 + (nt - 16) * 128;
#pragma unroll 1
            for (int i = 0; i < 16; ++i) {
                const int row = w * 32 + 2 * i + h2;
                const f32x4 v = *(const f32x4*)(Cs + row * CST + c);
                u32x2 o = {pk(v[0], v[1]), pk(v[2], v[3])};
                *(u32x2*)(dst + (size_t)row * 1024 + c) = o;
            }
        } else if (nt < 16) {
            twrite<128>(Cs, 0, (bf16_t*)(ws + A1_VT) + ((size_t)(b * 8 + (nt - 8)) * 128) * TT + t0, TT, nullptr);
        } else {
            float* mg = (float*)(ws + A1_G);
            if (l31 < 8) {
                const f32x4 gb = *(const f32x4*)(p.m_gate_b + c);
                const bool ls = ((c >> 3) & 1) != 0;
#pragma unroll 1
                for (int i = 0; i < 16; ++i) {
                    const int row = w * 32 + 2 * i + h2;
                    f32x4 v = *(const f32x4*)(Cs + row * CST + c); v = v + gb;
                    if (ls) { v[0] = logsigmoidf(v[0]); v[1] = logsigmoidf(v[1]); v[2] = logsigmoidf(v[2]); v[3] = logsigmoidf(v[3]); }
                    *(f32x4*)(mg + (size_t)(g0 + row) * 32 + c) = v;
                }
            }
        }
    }
};

DI f32x4 ld_nt(const float* q) { return __builtin_nontemporal_load((const f32x4*)q); }
DI void ln_phase(const Params& p, int layer, int which, int next_layer, int next_chunk  , int latonly, int bid, int nb, int nparts = 0, int gate_chunk = 0, int from_input = 0, int lazy_out = 0  , int lazy_src = 0  ) {
    const int tid = threadIdx.x, lane = tid & 63;
    const float* lg = p.ln_g + (size_t)(layer * 2 + which) * 1024; const float* lb = p.ln_b + (size_t)(layer * 2 + which) * 1024;
    const float* modv = (const float*)(p.ws + O_MODV);
    bf16_t* H = (bf16_t*)(p.ws + O_H);
    const int nrows = latonly ? NB * SEQ : RT;
    f32x4 gv[4], bv[4];
#pragma unroll
    for (int i = 0; i < 4; ++i) { gv[i] = *(const f32x4*)(lg + i * 256 + lane * 4); bv[i] = *(const f32x4*)(lb + i * 256 + lane * 4); }
    for (int r = bid * 4 + (tid >> 6); r < nrows; r += nb * 4) {
        const int g = latonly ? ((r >> 13) * TT + CTXL + (r & 8191)) : r;
        float* xr = xrow(p, g);
        f32x4 v[4]; float s = 0.f;
        const int tloc = g % TT;
        const bool assembled = nparts > 0 && tloc < CTXL;
        if (nparts > 0 && tloc < CTXL) {
            const float* xs = from_input ? xrow_in(p, g) : xr;
            const float* gate = modv + (size_t)(layer * 5 + 4) * 6144 + gate_chunk * 1024;
            const float* pp = (const float*)(p.ws + O_PART) + (size_t)((g / TT) * CTXL + tloc) * DM;
#pragma unroll
            for (int i = 0; i < 4; ++i) {
                f32x4 acc = *(const f32x4*)(pp + i * 256 + lane * 4);
                for (int q = 1; q < nparts; ++q) acc = acc + *(const f32x4*)(pp + (size_t)q * 1024 * DM + i * 256 + lane * 4);
                f32x4 xv = *(const f32x4*)(xs + i * 256 + lane * 4);
                if (lazy_src > 0) {
                    const float* st = (const float*)(p.ws + O_STATS) + (size_t)(lazy_src - 1) * RT * 8 + (size_t)g * 8;
                    const float mu0 = __hip_atomic_load(st, __ATOMIC_RELAXED, __HIP_MEMORY_SCOPE_AGENT), rs0 = __hip_atomic_load(st + 1, __ATOMIC_RELAXED, __HIP_MEMORY_SCOPE_AGENT);
                    const f32x4 g4 = *(const f32x4*)(p.ln_g + (size_t)(layer * 2 + 0) * 1024 + i * 256 + lane * 4), b4 = *(const f32x4*)(p.ln_b + (size_t)(layer * 2 + 0) * 1024 + i * 256 + lane * 4);
                    xv = (xv - mu0) * rs0 * g4 + b4;
                }
                v[i] = xv * ALPHA + *(const f32x4*)(gate + i * 256 + lane * 4) * acc;
            }
        } else {
#pragma unroll
            for (int i = 0; i < 4; ++i) v[i] = ld_nt(xr + i * 256 + lane * 4);
        }
#pragma unroll
        for (int i = 0; i < 4; ++i) s += (v[i][0] + v[i][1]) + (v[i][2] + v[i][3]);
#pragma unroll
        for (int o = 1; o < 64; o <<= 1) s += __shfl_xor(s, o);
        const float mu = s * (1.f / 1024.f); float q = 0.f;
#pragma unroll
        for (int i = 0; i < 4; ++i) { v[i] = v[i] - mu; q += (v[i][0] * v[i][0] + v[i][1] * v[i][1]) + (v[i][2] * v[i][2] + v[i][3] * v[i][3]); }
#pragma unroll
        for (int o = 1; o < 64; o <<= 1) q += __shfl_xor(q, o);
        const float rstd = rsqrtf(q * (1.f / 1024.f) + EPS);
        if (lazy_out > 0 && lane == 0) { float* st = (float*)(p.ws + O_STATS) + (size_t)(lazy_out - 1) * RT * 8 + (size_t)g * 8; __hip_atomic_store(st, mu, __ATOMIC_RELAXED, __HIP_MEMORY_SCOPE_AGENT); __hip_atomic_store(st + 1, rstd, __ATOMIC_RELAXED, __HIP_MEMORY_SCOPE_AGENT); }
        const int mi = modidx(g);
        const float* sh = modv + (size_t)(next_layer * 5 + mi) * 6144 + (next_chunk < 0 ? 0 : next_chunk) * 1024; const float* sc = sh + 1024;
#pragma unroll
        for (int i = 0; i < 4; ++i) {
            const f32x4 y = v[i] * rstd * gv[i] + bv[i];
            if (lazy_out == 0) *(f32x4*)(xr + i * 256 + lane * 4) = y;
            else if (assembled) *(f32x4*)(xr + i * 256 + lane * 4) = v[i] + mu;
            if (next_chunk >= 0) {
                const f32x4 s4 = *(const f32x4*)(sh + i * 256 + lane * 4), c4 = *(const f32x4*)(sc + i * 256 + lane * 4);
                const f32x4 h = y * (1.f + c4) + s4;
                u32x2 o = {pk(h[0], h[1]), pk(h[2], h[3])};
                *(u32x2*)(H + (size_t)g * 1024 + i * 256 + lane * 4) = o;
            }
        }
    }
}

DI void attn_softmax(f32x16 (&s)[2], float& m, float& l, f32x16 (&o)[2]) {
    float mx = fmaxf(s[0][0], s[1][0]);
#pragma unroll
    for (int r = 1; r < 16; ++r) mx = fmaxf(mx, fmaxf(s[0][r], s[1][r]));
    if (__builtin_amdgcn_ballot_w64(mx > m + 8.f) != 0ull) {
        mx = fmaxf(mx, __shfl_xor(mx, 32));
        const float mn = fmaxf(m, mx); const float alpha = __builtin_amdgcn_exp2f(m - mn); m = mn;
        l *= alpha;
#pragma unroll
        for (int r = 0; r < 16; ++r) { o[0][r] *= alpha; o[1][r] *= alpha; }
    }
    float ps = 0.f;
#pragma unroll
    for (int r = 0; r < 16; ++r) { s[0][r] = __builtin_amdgcn_exp2f(s[0][r] - m); s[1][r] = __builtin_amdgcn_exp2f(s[1][r] - m); ps += s[0][r] + s[1][r]; }
    l += ps;
}
DI void attn_pack(const f32x16 (&s)[2], s16x8 (&pf)[4]) {
#pragma unroll
    for (int kb = 0; kb < 2; ++kb)
#pragma unroll
        for (int sp = 0; sp < 2; ++sp)
            pf[kb * 2 + sp] = pack8(s[kb][8 * sp], s[kb][8 * sp + 1], s[kb][8 * sp + 2], s[kb][8 * sp + 3], s[kb][8 * sp + 4], s[kb][8 * sp + 5], s[kb][8 * sp + 6], s[kb][8 * sp + 7]);
}
DI void attn_pv(const s16x8 (&pf)[4], f32x16 (&o)[2], const bf16_t* Vc, int VST) {
#pragma unroll
    for (int kk = 0; kk < 4; ++kk) {
        const int ko = kk * 16;
#pragma unroll
        for (int vb = 0; vb < 2; ++vb) {
            const s16x4 lo = *(const s16x4*)(Vc + vb * 32 * VST + ko), hi = *(const s16x4*)(Vc + vb * 32 * VST + ko + 8);
            o[vb] = MFMA32(cat4(lo, hi), pf[kk], o[vb]);
        }
    }
}
DI void attn_sm2(f32x16 (&s)[2], float& m, float& l, f32x16 (&o)[2], s16x8 (&pf)[4]) {
    constexpr float THR = 4.f;
    float mx = s[0][0];
#pragma unroll
    for (int r = 0; r < 16; ++r) { mx = fmaxf(mx, s[0][r]); mx = fmaxf(mx, s[1][r]); }
    mx = fmaxf(mx, __shfl_xor(mx, 32));
    if (__builtin_amdgcn_ballot_w64(mx > m + THR) != 0ull) {
        const float mn = fmaxf(m, mx); const float alpha = __builtin_amdgcn_exp2f(m - mn); m = mn;
        l *= alpha;
#pragma unroll
        for (int r = 0; r < 16; ++r) { o[0][r] *= alpha; o[1][r] *= alpha; }
    }
    float ps = 0.f;
#pragma unroll
    for (int r = 0; r < 16; ++r) { s[0][r] = __builtin_amdgcn_exp2f(s[0][r] - m); s[1][r] = __builtin_amdgcn_exp2f(s[1][r] - m); ps += s[0][r] + s[1][r]; }
    l += ps;
#pragma unroll
    for (int kb = 0; kb < 2; ++kb)
#pragma unroll
        for (int sp = 0; sp < 2; ++sp)
            pf[kb * 2 + sp] = pack8(s[kb][8 * sp], s[kb][8 * sp + 1], s[kb][8 * sp + 2], s[kb][8 * sp + 3], s[kb][8 * sp + 4], s[kb][8 * sp + 5], s[kb][8 * sp + 6], s[kb][8 * sp + 7]);
}
DI void attn_pv2(const s16x8 (&pf)[4], f32x16 (&o)[2], const bf16_t* Vc, int VST) {
#pragma unroll
    for (int kk = 0; kk < 4; ++kk)
#pragma unroll
        for (int vb = 0; vb < 2; ++vb) {
            const s16x4 lo = *(const s16x4*)(Vc + vb * 32 * VST + kk * 16), hi = *(const s16x4*)(Vc + vb * 32 * VST + kk * 16 + 8);
            o[vb] = MFMA32(cat4(lo, hi), pf[kk], o[vb]);
        }
}
DI void attn_phase(const Params& p, char* lds, int bid, int nb) {
    constexpr int KST = 104, VST = 68;
    bf16_t* Ks = (bf16_t*)lds;
    bf16_t* Vs = Ks + 2 * 64 * KST;
    bf16_t* Qs = Vs + 2 * 64 * VST;
    const int tid = threadIdx.x, lane = tid & 63, w = tid >> 6, l31 = lane & 31, h2 = lane >> 5;
    char* ws = p.ws;
    const bf16_t* QB = (const bf16_t*)(ws + A0_QB); const bf16_t* KB = (const bf16_t*)(ws + A0_KB); const bf16_t* VT = (const bf16_t*)(ws + A0_VT);
    bf16_t* MIX = (bf16_t*)(ws + O_H);
    const int xcd = bid & 7, j = bid >> 3, per = nb >> 3;
    const int nlat = 128;
    for (int uu = j; uu < nlat + 4; uu += per) {
        int b, h, q0, nkt;
        if (uu < nlat) { const int bh = xcd + 8 * (uu >> 5); b = bh >> 3; h = bh & 7; q0 = CTXL + (uu & 31) * 256; nkt = TT / 64; }
        else { const int bh = xcd + 8 * (uu - nlat); b = bh >> 3; h = bh & 7; q0 = 0; nkt = CTXL / 64; }
        const size_t bh_ = (size_t)(b * 8 + h);
        const bf16_t* Qg = QB + (bh_ * TT + q0 + w * 64 + l31) * 96 + h2 * 8;
        s16x8 qfA[6];
        bf16_t* Qb = Qs + (w * 32 + l31) * KST + h2 * 8;
#pragma unroll
        for (int ks = 0; ks < 6; ++ks) { qfA[ks] = *(const s16x8*)(Qg + ks * 16); *(s16x8*)(Qb + ks * 16) = *(const s16x8*)(Qg + 32 * 96 + ks * 16); }
        const bf16_t* Kg = KB + bh_ * TT * 96;
        const bf16_t* Vg = VT + bh_ * 64 * TT;
        f32x16 oA[2], oB[2]; zero16(oA[0]); zero16(oA[1]); zero16(oB[0]); zero16(oB[1]);
        float mA = -1e30f, lA = 0.f, mB = -1e30f, lB = 0.f;
        u32x4 rk[3], rv[2];
#pragma unroll
        for (int i = 0; i < 3; ++i) { const int idx = tid + 256 * i; rk[i] = *(const u32x4*)(Kg + (size_t)idx * 8); }
#pragma unroll
        for (int i = 0; i < 2; ++i) { const int idx = tid + 256 * i, r = idx >> 3, c8 = idx & 7; rv[i] = *(const u32x4*)(Vg + (size_t)r * TT + c8 * 8); }
#pragma unroll
        for (int i = 0; i < 3; ++i) { const int idx = tid + 256 * i, r = idx / 12, c8 = idx - r * 12; *(u32x4*)(Ks + r * KST + c8 * 8) = rk[i]; }
#pragma unroll
        for (int i = 0; i < 2; ++i) { const int idx = tid + 256 * i, r = idx >> 3, c8 = idx & 7;
            u32x2 a = {rv[i][0], rv[i][1]}, bq = {rv[i][2], rv[i][3]};
            *(u32x2*)(Vs + r * VST + c8 * 8) = a; *(u32x2*)(Vs + r * VST + c8 * 8 + 4) = bq; }
        __syncthreads();
#pragma unroll 1
        for (int kt = 0; kt < nkt; ++kt) {
            const int cur = kt & 1;
            {
                const int kn = kt + 1 < nkt ? kt + 1 : kt;
                const bf16_t* Kn = Kg + (size_t)kn * 64 * 96; const bf16_t* Vn = Vg + kn * 64;
#pragma unroll
                for (int i = 0; i < 3; ++i) { const int idx = tid + 256 * i; rk[i] = *(const u32x4*)(Kn + (size_t)idx * 8); }
#pragma unroll
                for (int i = 0; i < 2; ++i) { const int idx = tid + 256 * i, r = idx >> 3, c8 = idx & 7; rv[i] = *(const u32x4*)(Vn + (size_t)r * TT + c8 * 8); }
            }
            const bf16_t* Kc = Ks + cur * 64 * KST + l31 * KST + h2 * 8;
            const bf16_t* Vc = Vs + cur * 64 * VST + l31 * VST + 4 * h2;
            s16x8 pfA[4], pfB[4];
            {
                f32x16 sA[2]; zero16(sA[0]); zero16(sA[1]);
#pragma unroll
                for (int ks = 0; ks < 6; ++ks) {
                    const s16x8 a0 = *(const s16x8*)(Kc + ks * 16), a1 = *(const s16x8*)(Kc + 32 * KST + ks * 16);
                    sA[0] = MFMA32(a0, qfA[ks], sA[0]); sA[1] = MFMA32(a1, qfA[ks], sA[1]);
                }
                attn_sm2(sA, mA, lA, oA, pfA);
            }
            __builtin_amdgcn_sched_barrier(0);
            {
                f32x16 sB[2]; zero16(sB[0]); zero16(sB[1]);
#pragma unroll 2
                for (int ks = 0; ks < 6; ++ks) {
                    const s16x8 a0 = *(const s16x8*)(Kc + ks * 16), a1 = *(const s16x8*)(Kc + 32 * KST + ks * 16);
                    const s16x8 qb = *(const s16x8*)(Qb + ks * 16);
                    sB[0] = MFMA32(a0, qb, sB[0]); sB[1] = MFMA32(a1, qb, sB[1]);
                }
                attn_pv2(pfA, oA, Vc, VST);
                attn_sm2(sB, mB, lB, oB, pfB);
            }
            __builtin_amdgcn_sched_barrier(0);
            attn_pv2(pfB, oB, Vc, VST);
            {
                bf16_t* Kw = Ks + (cur ^ 1) * 64 * KST; bf16_t* Vw = Vs + (cur ^ 1) * 64 * VST;
#pragma unroll
                for (int i = 0; i < 3; ++i) { const int idx = tid + 256 * i, r = idx / 12, c8 = idx - r * 12; *(u32x4*)(Kw + r * KST + c8 * 8) = rk[i]; }
#pragma unroll
                for (int i = 0; i < 2; ++i) { const int idx = tid + 256 * i, r = idx >> 3, c8 = idx & 7;
                    u32x2 a = {rv[i][0], rv[i][1]}, bq = {rv[i][2], rv[i][3]};
                    *(u32x2*)(Vw + r * VST + c8 * 8) = a; *(u32x2*)(Vw + r * VST + c8 * 8 + 4) = bq; }
            }
            __syncthreads();
        }
        lA += __shfl_xor(lA, 32); lB += __shfl_xor(lB, 32);
        const float invA = __builtin_amdgcn_rcpf(lA), invB = __builtin_amdgcn_rcpf(lB);
        bf16_t* dst = MIX + ((size_t)b * TT + q0 + w * 64 + l31) * 1024 + h * 64 + 4 * h2;
#pragma unroll
        for (int vb = 0; vb < 2; ++vb)
#pragma unroll
            for (int rg = 0; rg < 4; ++rg) {
                u32x2 ov = {pk(oA[vb][4 * rg] * invA, oA[vb][4 * rg + 1] * invA), pk(oA[vb][4 * rg + 2] * invA, oA[vb][4 * rg + 3] * invA)};
                *(u32x2*)(dst + vb * 32 + rg * 8) = ov;
                u32x2 ow = {pk(oB[vb][4 * rg] * invB, oB[vb][4 * rg + 1] * invB), pk(oB[vb][4 * rg + 2] * invB, oB[vb][4 * rg + 3] * invB)};
                *(u32x2*)(dst + (size_t)32 * 1024 + vb * 32 + rg * 8) = ow;
            }
    }
}

constexpr int RST = 136;
DI void load_tile128(bf16_t* dstl, const bf16_t* src, size_t ld) {
    const int tid = threadIdx.x;
#pragma unroll
    for (int i = 0; i < 8; ++i) { const int idx = tid + 256 * i, r = idx >> 4, c8 = idx & 15;
        *(u32x4*)(dstl + r * RST + c8 * 8) = *(const u32x4*)(src + (size_t)r * ld + c8 * 8); }
}
DI void ret_u_phase(const Params& p, char* lds, int bid, int nb) {
    bf16_t* Vt = (bf16_t*)lds;
    bf16_t* Kt = Vt + 128 * RST;
    const int tid = threadIdx.x, lane = tid & 63, w = tid >> 6, l31 = lane & 31, h2 = lane >> 5;
    char* ws = p.ws;
    const bf16_t* RK = (const bf16_t*)(ws + A0_RK); const bf16_t* RVT = (const bf16_t*)(ws + A0_RVT);
    bf16_t* RUS = (bf16_t*)(ws + A0_RUS);
    constexpr int RNU = NB * 4 * 66;
    const int rfull = RNU / nb, rrem = RNU - rfull * nb, rshift = (bid - 64 + nb) % nb;
    for (int it = 0; it < rfull + (rshift < rrem ? 1 : 0); ++it) {
        const int u = it < rfull ? bid + it * nb : rfull * nb + rshift;
        const int c = u % 66, bh = u / 66, h = bh & 3, b = bh >> 2;
        const int g0 = b * TT + c * 128;
        load_tile128(Vt, RVT + ((size_t)(b * 4 + h) * 128) * TT + c * 128, TT);
        const int pos = tid & 127, half = tid >> 7;
        u32x4 kr[8];
        const bf16_t* ksrc = RK + (size_t)(g0 + pos) * 512 + h * 128 + half * 64;
#pragma unroll
        for (int i = 0; i < 8; ++i) kr[i] = *(const u32x4*)(ksrc + i * 8);
        for (int dir = 0; dir < 2; ++dir) {
            const float lg = p.ret_ld[dir * 4 + h];
            const float wgt = __expf(lg * (dir == 0 ? (float)(127 - pos) : (float)pos));
            if (dir == 1) __syncthreads();
#pragma unroll
            for (int i = 0; i < 8; ++i)
#pragma unroll
                for (int e = 0; e < 4; ++e) {
                    const unsigned uu = kr[i][e];
                    Kt[(half * 64 + i * 8 + 2 * e) * RST + pos] = f2bf(bflo(uu) * wgt);
                    Kt[(half * 64 + i * 8 + 2 * e + 1) * RST + pos] = f2bf(bfhi(uu) * wgt);
                }
            __syncthreads();
            f32x16 acc[4];
#pragma unroll
            for (int ni = 0; ni < 4; ++ni) zero16(acc[ni]);
            const bf16_t* Ac = Vt + (w * 32 + l31) * RST + h2 * 8;
            const bf16_t* Bc = Kt + l31 * RST + h2 * 8;
#pragma unroll
            for (int ks = 0; ks < 8; ++ks) {
                const s16x8 a = *(const s16x8*)(Ac + ks * 16);
#pragma unroll
                for (int ni = 0; ni < 4; ++ni) { const s16x8 bb = *(const s16x8*)(Bc + ni * 32 * RST + ks * 16); acc[ni] = MFMA32(a, bb, acc[ni]); }
            }
            bf16_t* dst = RUS + ((size_t)((b * 4 + h) * 2 + dir) * 66 + c) * 16384;
#pragma unroll
            for (int ni = 0; ni < 4; ++ni)
#pragma unroll
                for (int r = 0; r < 16; ++r) dst[(w * 32 + crow(r, h2)) * 128 + ni * 32 + l31] = f2bf(acc[ni][r]);
        }
        __syncthreads();
    }
}

DI void ret_scan_phase(const Params& p, int bid, int nb) {
    const unsigned tid = threadIdx.x;
    unsigned* RUS = (unsigned*)(p.ws + A0_RUS);
    for (int blk = bid; blk < 1024; blk += nb) {
        const int seq = blk >> 5;
        const unsigned e = (unsigned)(blk & 31) * 256u + tid;
        const int dir = seq & 1, h = (seq >> 1) & 3;
        const float g128 = __expf(p.ret_ld[dir * 4 + h] * 128.f);
        unsigned* sbase = RUS + (size_t)seq * 66 * 8192;
        float r0 = 0.f, r1 = 0.f;
#pragma unroll 1
        for (int hf = 0; hf < 2; ++hf) {
            unsigned v[33];
#pragma unroll
            for (int j = 0; j < 33; ++j) { const int i = hf * 33 + j; const int c = dir == 0 ? i : (i < 2 ? 1 - i : 67 - i); v[j] = (sbase + (size_t)c * 8192)[e]; }
#pragma unroll
            for (int j = 0; j < 33; ++j) {
                const int i = hf * 33 + j; const int c = dir == 0 ? i : (i < 2 ? 1 - i : 67 - i);
                (sbase + (size_t)c * 8192)[e] = pk(r0, r1);
                r0 = g128 * r0 + bflo(v[j]); r1 = g128 * r1 + bfhi(v[j]);
            }
        }
    }
}

DI void ret_out_phase(const Params& p, char* lds, int bid, int nb) {
    bf16_t* B0 = (bf16_t*)lds;
    bf16_t* Vt = B0 + 128 * RST;
    const int tid = threadIdx.x, lane = tid & 63, w = tid >> 6, l31 = lane & 31, h2 = lane >> 5;
    char* ws = p.ws;
    const bf16_t* RQ = (const bf16_t*)(ws + A0_RQ); const bf16_t* RK = (const bf16_t*)(ws + A0_RK); const bf16_t* RVT = (const bf16_t*)(ws + A0_RVT);
    const bf16_t* RG = (const bf16_t*)(ws + A0_RG); const bf16_t* RUS = (const bf16_t*)(ws + A0_RUS);
    bf16_t* MIX = (bf16_t*)(ws + O_H);
    constexpr int RNU = NB * 4 * 66;
    const int rfull = RNU / nb, rrem = RNU - rfull * nb, rshift = (bid - 64 + nb) % nb;
    for (int it = 0; it < rfull + (rshift < rrem ? 1 : 0); ++it) {
        const int u = it < rfull ? bid + it * nb : rfull * nb + rshift;
        const int c = u % 66, bh = u / 66, h = bh & 3, b = bh >> 2;
        const int g0 = b * TT + c * 128;
        const float lgf = p.ret_ld[h] * 1.4426950408889634f, lgb = p.ret_ld[4 + h] * 1.4426950408889634f;
        load_tile128(B0, RK + (size_t)g0 * 512 + h * 128, 512);
        load_tile128(Vt, RVT + ((size_t)(b * 4 + h) * 128) * TT + c * 128, TT);
        const int qi = w * 32 + l31;
        s16x8 qf[8];
        const bf16_t* Qg = RQ + (size_t)(g0 + qi) * 512 + h * 128 + h2 * 8;
#pragma unroll
        for (int ks = 0; ks < 8; ++ks) qf[ks] = *(const s16x8*)(Qg + ks * 16);
        __syncthreads();
        f32x16 o[4];
#pragma unroll
        for (int vb = 0; vb < 4; ++vb) zero16(o[vb]);
#pragma unroll 1
        for (int jb = 0; jb < 4; ++jb) {
            f32x16 s; zero16(s);
            const bf16_t* Kc = B0 + (jb * 32 + l31) * RST + h2 * 8;
#pragma unroll
            for (int ks = 0; ks < 8; ++ks) s = MFMA32(*(const s16x8*)(Kc + ks * 16), qf[ks], s);
#pragma unroll
            for (int r = 0; r < 16; ++r) {
                const int jj = jb * 32 + crow(r, h2); const int d = qi - jj;
                const float dm = d > 0 ? __builtin_amdgcn_exp2f(lgf * (float)d) : (d < 0 ? __builtin_amdgcn_exp2f(lgb * (float)(-d)) : 2.f);
                s[r] *= dm;
            }
#pragma unroll
            for (int sp = 0; sp < 2; ++sp) {
                const s16x8 pf = pack8(s[8 * sp], s[8 * sp + 1], s[8 * sp + 2], s[8 * sp + 3], s[8 * sp + 4], s[8 * sp + 5], s[8 * sp + 6], s[8 * sp + 7]);
                const int ko = jb * 32 + sp * 16 + 4 * h2;
#pragma unroll
                for (int vb = 0; vb < 4; ++vb) {
                    const bf16_t* vp = Vt + (vb * 32 + l31) * RST + ko;
                    o[vb] = MFMA32(cat4(*(const s16x4*)vp, *(const s16x4*)(vp + 8)), pf, o[vb]);
                }
            }
        }
#pragma unroll 1
        for (int dir = 0; dir < 2; ++dir) {
            __syncthreads();
            load_tile128(B0, RUS + ((size_t)((b * 4 + h) * 2 + dir) * 66 + c) * 16384, 128);
            const float dq = __builtin_amdgcn_exp2f((dir == 0 ? lgf * (float)(qi + 1) : lgb * (float)(128 - qi)));
            __syncthreads();
#pragma unroll
            for (int ks = 0; ks < 8; ++ks) {
                const u32x4 qq = __builtin_bit_cast(u32x4, qf[ks]);
                const s16x8 qs = pack8(bflo(qq[0]) * dq, bfhi(qq[0]) * dq, bflo(qq[1]) * dq, bfhi(qq[1]) * dq, bflo(qq[2]) * dq, bfhi(qq[2]) * dq, bflo(qq[3]) * dq, bfhi(qq[3]) * dq);
#pragma unroll
                for (int vb = 0; vb < 4; ++vb) o[vb] = MFMA32(*(const s16x8*)(B0 + (vb * 32 + l31) * RST + h2 * 8 + ks * 16), qs, o[vb]);
            }
        }
        float sm = 0.f;
#pragma unroll
        for (int vb = 0; vb < 4; ++vb)
#pragma unroll
            for (int r = 0; r < 16; ++r) sm += o[vb][r];
        sm += __shfl_xor(sm, 32);
        const float mu = sm * (1.f / 128.f); float q = 0.f;
#pragma unroll
        for (int vb = 0; vb < 4; ++vb)
#pragma unroll
            for (int r = 0; r < 16; ++r) { o[vb][r] -= mu; q += o[vb][r] * o[vb][r]; }
        q += __shfl_xor(q, 32);
        const float rstd = rsqrtf(q * (1.f / 128.f) + EPS);
        const bf16_t* gsrc = RG + (size_t)(g0 + qi) * 512 + h * 128 + 4 * h2;
        bf16_t* dst = MIX + (size_t)(g0 + qi) * 1024 + 512 + h * 128 + 4 * h2;
#pragma unroll
        for (int vb = 0; vb < 4; ++vb)
#pragma unroll
            for (int rg = 0; rg < 4; ++rg) {
                const u32x2 gg = *(const u32x2*)(gsrc + vb * 32 + rg * 8);
                const float g0v = siluf(bflo(gg[0])), g1v = siluf(bfhi(gg[0])), g2v = siluf(bflo(gg[1])), g3v = siluf(bfhi(gg[1]));
                u32x2 ov = {pk(g0v * o[vb][4 * rg] * rstd, g1v * o[vb][4 * rg + 1] * rstd), pk(g2v * o[vb][4 * rg + 2] * rstd, g3v * o[vb][4 * rg + 3] * rstd)};
                *(u32x2*)(dst + vb * 32 + rg * 8) = ov;
            }
        __syncthreads();
    }
}

DI void mconv_phase(const Params& p, int bid, int nb) {
    const int tid = threadIdx.x; const int gtid = bid * NTHR + tid, gthreads = nb * NTHR;
    const float* HALO = (const float*)(p.ws + A1_HALO);
    bf16_t* POST = (bf16_t*)(p.ws + A1_QKPRE);
    for (int it = gtid; it < (RT / 128) * 2 * 256; it += gthreads) {
        const int c4 = (it & 255) * 4, which = (it >> 8) & 1, hidx = it >> 9;
        const int hb = hidx % 66;
        const float* hh = HALO + (size_t)hidx * 4 * 1024 + c4;
        const f32x4 z = {0.f, 0.f, 0.f, 0.f};
        f32x4 xm, x0, xp; int row;
        if (which == 0) { row = 0; x0 = *(const f32x4*)hh; xp = *(const f32x4*)(hh + 1024); xm = (hb == 0 || hb == 2) ? z : *(const f32x4*)(hh - 4 * 1024 + 3 * 1024); }
        else { row = 127; xm = *(const f32x4*)(hh + 2 * 1024); x0 = *(const f32x4*)(hh + 3 * 1024); xp = (hb == 1 || hb == 65) ? z : *(const f32x4*)(hh + 4 * 1024); }
        const f32x4 w0 = *(const f32x4*)(p.m_conv_w + c4), w1 = *(const f32x4*)(p.m_conv_w + 1024 + c4), w2 = *(const f32x4*)(p.m_conv_w + 2048 + c4), bb = *(const f32x4*)(p.m_conv_b + c4);
        const float scl = c4 >= 512 ? 0.125f : 1.f;
        const f32x4 a = xm * w0 + x0 * w1 + xp * w2 + bb;
        u32x2 o = {pk(siluf(a[0]) * scl, siluf(a[1]) * scl), pk(siluf(a[2]) * scl, siluf(a[3]) * scl)};
        *(u32x2*)(POST + (size_t)(hidx * 128 + row) * 1024 + c4) = o;
    }
}

constexpr int MST = 72;
DI void mlstm_u_phase(const Params& p, char* lds, int bid, int nb) {
    bf16_t* Vt = (bf16_t*)lds;
    bf16_t* Ktf = Vt + 128 * MST;
    bf16_t* Ktb = Ktf + 64 * MST;
    float* gt = (float*)(Ktb + 64 * MST);
    float* wt = gt + 256; float* scal = wt + 128;
    const int tid = threadIdx.x, lane = tid & 63, w = tid >> 6, l31 = lane & 31, h2 = lane >> 5;
    char* ws = p.ws;
    const bf16_t* QK = (const bf16_t*)(ws + A1_QKPRE); const bf16_t* MVT = (const bf16_t*)(ws + A1_VT); const float* MG = (const float*)(ws + A1_G);
    bf16_t* MU = (bf16_t*)(ws + A1_U); float* MN = (float*)(ws + A1_N); float* MSC = (float*)(ws + A1_SC);
    for (int u = bid; u < NB * 8 * 132; u += nb) {
        const int c = u % 132, bh = u / 132, h = bh & 7, b = bh >> 3;
        const int g0 = b * TT + c * 64;
        { const int kind = tid >> 6, s = tid & 63; gt[kind * 64 + s] = MG[(size_t)(g0 + s) * 32 + kind * 8 + h]; }
#pragma unroll
        for (int i = 0; i < 4; ++i) { const int idx = tid + 256 * i, r = idx >> 3, c8 = idx & 7;
            *(u32x4*)(Vt + r * MST + c8 * 8) = *(const u32x4*)(MVT + ((size_t)(b * 8 + h) * 128 + r) * TT + c * 64 + c8 * 8); }
        const int pos = tid & 63, qd = tid >> 6;
        const bf16_t* ksrc = QK + (size_t)(g0 + pos) * 1024 + 512 + h * 64 + qd * 16;
        const u32x4 k0 = *(const u32x4*)ksrc, k1 = *(const u32x4*)(ksrc + 8);
        __syncthreads();
        if (tid < 2) {
            if (tid == 0) {
                float run = 0.f, mx = -1e30f;
                for (int s = 63; s >= 0; --s) { const float lw = run + gt[s]; wt[s] = lw; mx = fmaxf(mx, lw); run += gt[64 + s]; }
                scal[0] = mx; scal[1] = run;
            } else {
                float run = 0.f, mx = -1e30f;
                for (int s = 0; s < 64; ++s) { const float lw = run + gt[128 + s]; wt[64 + s] = lw; mx = fmaxf(mx, lw); run += gt[192 + s]; }
                scal[2] = mx; scal[3] = run;
            }
        }
        __syncthreads();
        const float wf = __expf(wt[pos] - scal[0]), wb = __expf(wt[64 + pos] - scal[2]);
#pragma unroll
        for (int e = 0; e < 4; ++e) {
            const int dk = qd * 16 + 2 * e;
            Ktf[dk * MST + pos] = f2bf(bflo(k0[e]) * wf); Ktf[(dk + 1) * MST + pos] = f2bf(bfhi(k0[e]) * wf);
            Ktf[(dk + 8) * MST + pos] = f2bf(bflo(k1[e]) * wf); Ktf[(dk + 9) * MST + pos] = f2bf(bfhi(k1[e]) * wf);
            Ktb[dk * MST + pos] = f2bf(bflo(k0[e]) * wb); Ktb[(dk + 1) * MST + pos] = f2bf(bfhi(k0[e]) * wb);
            Ktb[(dk + 8) * MST + pos] = f2bf(bflo(k1[e]) * wb); Ktb[(dk + 9) * MST + pos] = f2bf(bfhi(k1[e]) * wb);
        }
        __syncthreads();
        const size_t sidx0 = (size_t)((b * 8 + h) * 2) * 132 + c;
        if (tid < 128) {
            const int dir = tid >> 6, dk = tid & 63; const bf16_t* row = (dir ? Ktb : Ktf) + dk * MST; float s = 0.f;
            for (int i = 0; i < 64; ++i) s += bf2f(row[i]);
            MN[(sidx0 + dir * 132) * 64 + dk] = s;
        } else if (tid < 130) {
            const int dir = tid - 128;
            MSC[(sidx0 + dir * 132) * 4 + 0] = scal[dir * 2]; MSC[(sidx0 + dir * 132) * 4 + 1] = scal[dir * 2 + 1];
        }
#pragma unroll 1
        for (int dir = 0; dir < 2; ++dir) {
            f32x16 acc[2]; zero16(acc[0]); zero16(acc[1]);
            const bf16_t* Ac = Vt + (w * 32 + l31) * MST + h2 * 8;
            const bf16_t* Bc = (dir ? Ktb : Ktf) + l31 * MST + h2 * 8;
#pragma unroll
            for (int ks = 0; ks < 4; ++ks) {
                const s16x8 a = *(const s16x8*)(Ac + ks * 16);
                acc[0] = MFMA32(a, *(const s16x8*)(Bc + ks * 16), acc[0]); acc[1] = MFMA32(a, *(const s16x8*)(Bc + 32 * MST + ks * 16), acc[1]);
            }
            bf16_t* dst = MU + (sidx0 + dir * 132) * 8192;
#pragma unroll
            for (int ni = 0; ni < 2; ++ni)
#pragma unroll
                for (int r = 0; r < 16; ++r) dst[(w * 32 + crow(r, h2)) * 64 + ni * 32 + l31] = f2bf(acc[ni][r]);
        }
        __syncthreads();
    }
}

DI int mchunk(int dir, int i) { return dir == 0 ? i : (i < 4 ? 3 - i : 135 - i); }
DI void mlstm_scan_phase(const Params& p, char* lds, int bid, int nb) {
    const int tid = threadIdx.x;
    unsigned* MU = (unsigned*)(p.ws + A1_U); float* MN = (float*)(p.ws + A1_N); float* MSC = (float*)(p.ws + A1_SC);
    float* la = (float*)lds;
    float* lu = la + 132;
    float* lml = lu + 132;
    float* lbe = lml + 132;
    for (int blk = bid; blk < 1024; blk += nb) {
        const int seq = blk >> 4;
        const int part = blk & 15;
        const int e = part * 256 + tid; const int dir = seq & 1;
        float* sc = MSC + (size_t)seq * 132 * 4;
        if (tid < 132) { const int c = mchunk(dir, tid); lml[tid] = sc[c * 4]; lbe[tid] = sc[c * 4 + 1]; }
        __syncthreads();
        if (tid == 0) {
            float m = 0.f;
            for (int i = 0; i < 132; ++i) {
                const float mloc = lml[i], bend = lbe[i];
                const float mnew = fmaxf(bend + m, mloc);
                la[i] = __expf(bend + m - mnew); lu[i] = __expf(mloc - mnew);
                if (part == 0) sc[mchunk(dir, i) * 4 + 2] = m;
                m = mnew;
            }
        }
        __syncthreads();
        unsigned* sbase = MU + (size_t)seq * 132 * 4096;
        const unsigned eu = (unsigned)e;
        float r0 = 0.f, r1 = 0.f;
#pragma unroll 1
        for (int hf = 0; hf < 4; ++hf) {
            unsigned v[33];
#pragma unroll
            for (int j = 0; j < 33; ++j) v[j] = (sbase + (size_t)mchunk(dir, hf * 33 + j) * 4096)[eu];
#pragma unroll
            for (int j = 0; j < 33; ++j) {
                const int i = hf * 33 + j;
                (sbase + (size_t)mchunk(dir, i) * 4096)[eu] = pk(r0, r1);
                const float a = la[i], uw = lu[i];
                r0 = a * r0 + uw * bflo(v[j]); r1 = a * r1 + uw * bfhi(v[j]);
            }
        }
        if (part == 1 && tid < 64) {
            float* nbase = MN + (size_t)seq * 132 * 64; float rn = 0.f; const unsigned tu = (unsigned)tid;
#pragma unroll 1
            for (int hf = 0; hf < 4; ++hf) {
                float v[33];
#pragma unroll
                for (int j = 0; j < 33; ++j) v[j] = (nbase + (size_t)mchunk(dir, hf * 33 + j) * 64)[tu];
#pragma unroll
                for (int j = 0; j < 33; ++j) { const int i = hf * 33 + j; (nbase + (size_t)mchunk(dir, i) * 64)[tu] = rn; rn = la[i] * rn + lu[i] * v[j]; }
            }
        }
        __syncthreads();
    }
}

DI void mlstm_out_phase(const Params& p, char* lds, int bid, int nb) {
    bf16_t* Qs = (bf16_t*)lds;
    bf16_t* Ks = Qs + 64 * MST;
    bf16_t* Vt = Ks + 64 * MST;
    bf16_t* Cf = Vt + 128 * MST;
    bf16_t* Cb = Cf + 128 * MST;
    float* HX = (float*)lds;
    float* tb = (float*)(lds + 73728);
    float* tn = tb + 384; float* gt = tn + 128;
    constexpr int HST = 68;
    const int tid = threadIdx.x, lane = tid & 63, w = tid >> 6, l31 = lane & 31, h2 = lane >> 5;
    char* ws = p.ws;
    const bf16_t* QK = (const bf16_t*)(ws + A1_QKPRE); const bf16_t* MVT = (const bf16_t*)(ws + A1_VT); const float* MG = (const float*)(ws + A1_G);
    const bf16_t* MU = (const bf16_t*)(ws + A1_U); const float* MN = (const float*)(ws + A1_N); const float* MSC = (const float*)(ws + A1_SC);
    const bf16_t* OG = (const bf16_t*)(ws + A1_OG); bf16_t* MIXM = (bf16_t*)(ws + O_H);
    u32x4 pq[2], pk_[2], pv[4], pcf[4], pcb[4]; float pg = 0.f, pn = 0.f, pmc = 0.f;
#define MO_LOAD(U) { int tl = threadIdx.x; asm volatile("" : "+v"(tl)); const int cl_ = (U) & 127, bh_ = (U) >> 7, h_ = bh_ & 7, b_ = bh_ >> 3; const int c_ = cl_ + 4; const int g0_ = b_ * TT + c_ * 64; \
        const size_t si_ = (size_t)((b_ * 8 + h_) * 2) * 132 + c_; \
        pg = MG[(size_t)(g0_ + (tl & 63)) * 32 + (tl >> 6) * 8 + h_]; \
        pn = MN[(si_ + ((tl >> 6) & 1) * 132) * 64 + (tl & 63)]; \
        pmc = MSC[(si_ + (tl >> 7) * 132) * 4 + 2]; \
        _Pragma("unroll") for (int i = 0; i < 2; ++i) { const int idx = tl + 256 * i, r = idx >> 3, c8 = idx & 7; \
            pq[i] = *(const u32x4*)(QK + (size_t)(g0_ + r) * 1024 + h_ * 64 + c8 * 8); \
            pk_[i] = *(const u32x4*)(QK + (size_t)(g0_ + r) * 1024 + 512 + h_ * 64 + c8 * 8); } \
        _Pragma("unroll") for (int i = 0; i < 4; ++i) { const int idx = tl + 256 * i, r = idx >> 3, c8 = idx & 7; \
            pv[i] = *(const u32x4*)(MVT + ((size_t)(b_ * 8 + h_) * 128 + r) * TT + c_ * 64 + c8 * 8); \
            pcf[i] = *(const u32x4*)(MU + si_ * 8192 + r * 64 + c8 * 8); \
            pcb[i] = *(const u32x4*)(MU + (si_ + 132) * 8192 + r * 64 + c8 * 8); } }
    if (bid < NB * 8 * 128) MO_LOAD(bid)
    for (int u = bid; u < NB * 8 * 128; u += nb) {
        const int cl = u & 127, bh = u >> 7, h = bh & 7, b = bh >> 3; const int c = cl + 4;
        const int g0 = b * TT + c * 64;
        const size_t sidx0 = (size_t)((b * 8 + h) * 2) * 132 + c;
        int tl2 = threadIdx.x; asm volatile("" : "+v"(tl2));
        gt[tl2] = pg;
        if (tl2 < 128) tn[tl2] = pn;
        const float mc_pre = pmc;
        u32x4 ogpre[4];
        { const bf16_t* ogp = OG + (size_t)(g0 + (tl2 >> 2)) * 1024 + h * 128 + (tl2 & 3) * 32;
#pragma unroll
          for (int i = 0; i < 4; ++i) ogpre[i] = *(const u32x4*)(ogp + i * 8); }
#pragma unroll
        for (int i = 0; i < 2; ++i) { const int idx = tl2 + 256 * i, r = idx >> 3, c8 = idx & 7;
            *(u32x4*)(Qs + r * MST + c8 * 8) = pq[i]; *(u32x4*)(Ks + r * MST + c8 * 8) = pk_[i]; }
#pragma unroll
        for (int i = 0; i < 4; ++i) { const int idx = tl2 + 256 * i, r = idx >> 3, c8 = idx & 7;
            *(u32x4*)(Vt + r * MST + c8 * 8) = pv[i]; *(u32x4*)(Cf + r * MST + c8 * 8) = pcf[i]; *(u32x4*)(Cb + r * MST + c8 * 8) = pcb[i]; }
        __syncthreads();
        if (w < 2) {
            const int sidx = lane;
            float run = gt[(w == 0 ? 64 : 192) + sidx];
            const float gi = gt[(w == 0 ? 0 : 128) + sidx];
            if (w == 0) {
#pragma unroll
                for (int o = 1; o < 64; o <<= 1) { const float v = __shfl_up(run, o); if (lane >= o) run += v; }
            } else {
#pragma unroll
                for (int o = 1; o < 64; o <<= 1) { const float v = __shfl_down(run, o); if (lane + o < 64) run += v; }
            }
            const float a = gi - run; float mx = a;
            if (w == 0) {
#pragma unroll
                for (int o = 1; o < 64; o <<= 1) { const float v = __shfl_up(mx, o); if (lane >= o) mx = fmaxf(mx, v); }
            } else {
#pragma unroll
                for (int o = 1; o < 64; o <<= 1) { const float v = __shfl_down(mx, o); if (lane + o < 64) mx = fmaxf(mx, v); }
            }
            float* T0 = tb + w * 192;
            T0[sidx] = run; T0[64 + sidx] = a; T0[128 + sidx] = mx;
        }
        __syncthreads();
        const int dir = w >> 1, tq = (w & 1) * 32 + l31;
        const float* T = tb + dir * 192;
        const float mc = mc_pre;
        const float bq = T[tq]; const float mt = bq + fmaxf(mc, T[128 + tq]);
        const float et = bq - mt; const float winter = __expf(bq + mc - mt);
        s16x8 qf[4];
#pragma unroll
        for (int ks = 0; ks < 4; ++ks) qf[ks] = *(const s16x8*)(Qs + tq * MST + ks * 16 + h2 * 8);
        f32x16 acc[4];
#pragma unroll
        for (int vb = 0; vb < 4; ++vb) zero16(acc[vb]);
        const bf16_t* Cc = (dir ? Cb : Cf) + l31 * MST + h2 * 8;
#pragma unroll
        for (int ks = 0; ks < 4; ++ks)
#pragma unroll
            for (int vb = 0; vb < 4; ++vb) acc[vb] = MFMA32(*(const s16x8*)(Cc + vb * 32 * MST + ks * 16), qf[ks], acc[vb]);
#pragma unroll
        for (int vb = 0; vb < 4; ++vb)
#pragma unroll
            for (int r = 0; r < 16; ++r) acc[vb][r] *= winter;
        float qn = 0.f;
        { const float* nv = tn + dir * 64 + h2 * 32; const bf16_t* qr = Qs + tq * MST + h2 * 32;
#pragma unroll
          for (int d = 0; d < 32; d += 2) { const unsigned uu = *(const unsigned*)(qr + d); qn += bflo(uu) * nv[d] + bfhi(uu) * nv[d + 1]; } }
        qn += __shfl_xor(qn, 32);
        float den = 0.f;
        f32x16 s[2]; zero16(s[0]); zero16(s[1]);
        const bf16_t* Kc = Ks + l31 * MST + h2 * 8;
#pragma unroll
        for (int ks = 0; ks < 4; ++ks) { s[0] = MFMA32(*(const s16x8*)(Kc + ks * 16), qf[ks], s[0]); s[1] = MFMA32(*(const s16x8*)(Kc + 32 * MST + ks * 16), qf[ks], s[1]); }
#pragma unroll
        for (int sb = 0; sb < 2; ++sb)
#pragma unroll
            for (int r = 0; r < 16; ++r) {
                const int sp = sb * 32 + crow(r, h2);
                const bool ok = dir == 0 ? (sp <= tq) : (sp >= tq);
                const float g = ok ? __expf(et + T[64 + sp]) : 0.f;
                s[sb][r] *= g; den += s[sb][r];
            }
        den += __shfl_xor(den, 32);
        den += winter * qn;
#pragma unroll
        for (int sb = 0; sb < 2; ++sb)
#pragma unroll
            for (int sp = 0; sp < 2; ++sp) {
                const s16x8 pf = pack8(s[sb][8 * sp], s[sb][8 * sp + 1], s[sb][8 * sp + 2], s[sb][8 * sp + 3], s[sb][8 * sp + 4], s[sb][8 * sp + 5], s[sb][8 * sp + 6], s[sb][8 * sp + 7]);
                const int ko = sb * 32 + sp * 16 + 4 * h2;
#pragma unroll
                for (int vb = 0; vb < 4; ++vb) {
                    const bf16_t* vp = Vt + (vb * 32 + l31) * MST + ko;
                    acc[vb] = MFMA32(cat4(*(const s16x4*)vp, *(const s16x4*)(vp + 8)), pf, acc[vb]);
                }
            }
        const float hden = __builtin_amdgcn_rcpf(fmaxf(fabsf(den), __expf(-mt)));
        __syncthreads();
#pragma unroll
        for (int vb = 0; vb < 4; ++vb)
#pragma unroll
            for (int r = 0; r < 16; ++r) HX[(dir * 128 + vb * 32 + crow(r, h2)) * HST + tq] = acc[vb][r] * hden;
        __builtin_amdgcn_sched_barrier(0);
        if (u + nb < NB * 8 * 128) MO_LOAD(u + nb)
        __builtin_amdgcn_sched_barrier(0);
        __syncthreads();
        {
            const int t = tid >> 2, q4 = tid & 3;
            float hv[32]; float sm = 0.f;
#pragma unroll
            for (int i = 0; i < 32; ++i) { const int dv = q4 * 32 + i; hv[i] = HX[dv * HST + t] + HX[(128 + dv) * HST + t]; sm += hv[i]; }
            sm += __shfl_xor(sm, 1); sm += __shfl_xor(sm, 2);
            const float mu = sm * (1.f / 128.f); float q = 0.f;
#pragma unroll
            for (int i = 0; i < 32; ++i) { hv[i] -= mu; q += hv[i] * hv[i]; }
            q += __shfl_xor(q, 1); q += __shfl_xor(q, 2);
            const float rstd = rsqrtf(q * (1.f / 128.f) + EPS);
            const bf16_t* og = OG + (size_t)(g0 + t) * 1024 + h * 128 + q4 * 32;
            bf16_t* mixo = MIXM + (size_t)(g0 + t) * 1024 + h * 128 + q4 * 32;
            const float* ng = p.m_norm_g + h * 128 + q4 * 32;
#pragma unroll
            for (int i = 0; i < 4; ++i) {
                const u32x4 gg = ogpre[i];
                float y[8];
#pragma unroll
                for (int e = 0; e < 4; ++e) {
                    y[2 * e] = sigmf(bflo(gg[e])) * hv[i * 8 + 2 * e] * rstd * ng[i * 8 + 2 * e];
                    y[2 * e + 1] = sigmf(bfhi(gg[e])) * hv[i * 8 + 2 * e + 1] * rstd * ng[i * 8 + 2 * e + 1];
                }
                u32x4 ov = {pk(y[0], y[1]), pk(y[2], y[3]), pk(y[4], y[5]), pk(y[6], y[7])};
                *(u32x4*)(mixo + i * 8) = ov;
            }
        }
        __syncthreads();
    }
}


#undef MO_LOAD
#define XB_TMO      128
#define XB_XCNT(j)  (256  + 64 * (j))
#define XB_XSUB(j)  (1280 + 64 * (j))
#define XB_XGEN(j)  (2304 + 64 * (j))
#define XB_TOP      3328
#define XB_TOPGEN   3392
#define XCD_BAR_WORDS 3456
#define XB_SPIN_CAP (1u << 18)
#define LAS __attribute__((address_space(3)))
DI unsigned xb_ld(unsigned* p)              { return __hip_atomic_load(p, __ATOMIC_RELAXED, __HIP_MEMORY_SCOPE_AGENT); }
DI unsigned xb_add(unsigned* p, unsigned v) { return __hip_atomic_fetch_add(p, v, __ATOMIC_RELAXED, __HIP_MEMORY_SCOPE_AGENT); }
DI unsigned xb_xcc_id() { return (unsigned)__builtin_amdgcn_s_getreg((3 << 11) | 20) & 0xFu; }
#define XB_SPIN(cond, bar) do { unsigned _sp = 0; while (cond) { __builtin_amdgcn_s_sleep(1); \
    if ((++_sp & 255u) == 0u) { if (xb_ld(&(bar)[XB_TMO])) break; if (_sp > XB_SPIN_CAP) { atomicAdd(&(bar)[XB_TMO], 1u); break; } } } } while (0)
struct XcdBarrier { unsigned* bar; unsigned x; volatile LAS unsigned* st; };
DI XcdBarrier xcd_barrier_post(unsigned* bar, volatile LAS unsigned* st) {
    XcdBarrier b; b.bar = bar; b.x = xb_xcc_id(); b.st = st;
    if (threadIdx.x == 0) (void)xb_add(&bar[XB_XCNT(b.x)], 1u);
    return b;
}
DI void xcd_barrier_complete(unsigned* bar, unsigned x, unsigned& nloc, unsigned& nx) {
    const unsigned G = gridDim.x * gridDim.y * gridDim.z;
    unsigned sum, cnt, mine, sp = 0u;
    for (;;) {
        sum = 0u; cnt = 0u; mine = 0u;
#pragma unroll
        for (unsigned j = 0; j < 16; ++j) { const unsigned c = xb_ld(&bar[XB_XCNT(j)]); sum += c; cnt += (c > 0u) ? 1u : 0u; mine = (j == x) ? c : mine; }
        if (sum == G) break;
        __builtin_amdgcn_s_sleep(1);
        if ((++sp & 255u) == 0u) { if (xb_ld(&bar[XB_TMO])) break; if (sp > XB_SPIN_CAP) { atomicAdd(&bar[XB_TMO], 1u); break; } }
    }
    nloc = mine > 0u ? mine : 1u; nx = cnt > 0u ? cnt : 1u;
}
DI void xcd_barrier(const XcdBarrier& b) {
    asm volatile("s_waitcnt vmcnt(0)" ::: "memory");
    __syncthreads();
    if (threadIdx.x == 0) {
        unsigned* bar = b.bar;
        __builtin_amdgcn_s_waitcnt(0);
        unsigned nloc = b.st[0], nx = b.st[1];
        if (nloc == 0u) { xcd_barrier_complete(bar, b.x, nloc, nx); b.st[0] = nloc; b.st[1] = nx; }
        const unsigned old = xb_add(&bar[XB_XSUB(b.x)], 1u);
        const unsigned gen = old / nloc;
        if (old + 1u == (gen + 1u) * nloc) {
            __builtin_amdgcn_fence(__ATOMIC_RELEASE, "agent");
            asm volatile("s_waitcnt vmcnt(0)" ::: "memory");
            const unsigned og = xb_add(&bar[XB_TOP], 1u);
            const unsigned tg = og / nx;
            if (og + 1u == (tg + 1u) * nx) xb_add(&bar[XB_TOPGEN], 1u);
            else XB_SPIN(xb_ld(&bar[XB_TOPGEN]) == tg, bar);
            __builtin_amdgcn_fence(__ATOMIC_ACQUIRE, "agent");
            xb_add(&bar[XB_XGEN(b.x)], 1u);
            asm volatile("s_waitcnt vmcnt(0)" ::: "memory");
        } else {
            XB_SPIN(xb_ld(&bar[XB_XGEN(b.x)]) == gen, bar);
            __builtin_amdgcn_fence(__ATOMIC_ACQUIRE, "agent");
            asm volatile("s_waitcnt vmcnt(0)" ::: "memory");
        }
    }
    __syncthreads();
}

constexpr int NPHASE = 21;
__global__ void __launch_bounds__(NTHR, 2) fwd_kernel(Params p) {
    extern __shared__ __attribute__((aligned(16))) char lds[];
    const int bid = blockIdx.x, nb = gridDim.x;
    char* ws = p.ws;
#if !MULTI_LAUNCH
    cg::grid_group grid = cg::this_grid();
    if (p.ph_hi > 1000) grid.sync();
    volatile LAS unsigned* xst = (volatile LAS unsigned*)(LAS char*)(lds + LDS_BYTES - 16);
    if (threadIdx.x == 0) { xst[0] = 0u; xst[1] = 0u; }
    __syncthreads();
    XcdBarrier xbar = xcd_barrier_post((unsigned*)(ws + O_BAR), xst);
#define SYNC() xcd_barrier(xbar)
#else
#define SYNC() do {} while (0)
#endif
#ifdef ONLY_PHASE
#define PHON(n) ((n) == ONLY_PHASE)
#else
#define PHON(n) true
#endif
#ifndef DUP_MASK
#define DUP_MASK 0u
#endif
#define PHASE(n, ...) if constexpr (PHON(n)) { if (p.ph_lo <= (n) && (n) < p.ph_hi) { if ((n) > p.ph_lo) SYNC(); __VA_ARGS__ if constexpr (((DUP_MASK >> (n)) & 1u) != 0u) { SYNC(); __VA_ARGS__ } } }
    PHASE(0, phase_prologue(p, lds, bid, nb);)
    PHASE(1, phase_modulate0(p, bid, nb);)
    PHASE(2, { GemmArgs ga{(const bf16_t*)(ws + O_H), 1024, (const bf16_t*)(ws + W_ABIN), 1024, 1024, RT / 256, 22, 0, 1}; EpiAbIn e{p}; gemm_phase(ga, e, lds, bid, nb); })
    PHASE(3, {
            GemmArgs g1{(const bf16_t*)(ws + A0_CQ), 384, (const bf16_t*)(ws + W_UQ), 384, 384, RT / 256, 6, 0, 1}; EpiUq e1{p}; gemm_phase(g1, e1, lds, bid, nb);
            GemmArgs g2{(const bf16_t*)(ws + A0_CKV), 256, (const bf16_t*)(ws + W_UKV), 256, 256, RT / 256, 8, 0, 1}; EpiUkv e2{p}; gemm_phase(g2, e2, lds, bid, nb);
            ret_u_phase(p, lds, bid, nb);
        })
    PHASE(4, ret_scan_phase(p, bid, nb);)
    PHASE(5, { attn_phase(p, lds, bid, nb); ret_out_phase(p, lds, bid, nb); })
    PHASE(6, { GemmArgs ga{(const bf16_t*)(ws + O_H), 1024, (const bf16_t*)(ws + W_ABOUT), 1024, 1024, 128, 8, 1, 1}; EpiResid e{p, 0, 2, 1, 0, 0, 0, 0}; gemm_phase(ga, e, lds, bid, nb);
        GemmArgs gc{(const bf16_t*)(ws + O_H), 1024, (const bf16_t*)(ws + W_ABOUT), 1024, 1024, 4, 8, 2, 16}; EpiResid ec{p, 0, 2, 1, 1, 0, 0, 0}; gemm_phase(gc, ec, lds, bid, nb); })
    PHASE(7, ln_phase(p, 0, 0, 0, 3, 0, bid, nb, 16, 2, 1, 1, 0);)
    PHASE(8, { GemmArgs ga{(const bf16_t*)(ws + O_H), 1024, (const bf16_t*)(ws + W_FFIN), 1024, 1024, RT / 256, 44, 0, 1}; EpiFfIn e{p}; gemm_phase(ga, e, lds, bid, nb); })
    PHASE(9, { GemmArgs ga{(const bf16_t*)(ws + O_ACT), DFF, (const bf16_t*)(ws + W_FFOUT), DFF, DFF, 128, 8, 1, 1}; EpiResid e{p, 0, 5, 0, 0, 1, 0, 0}; gemm_phase(ga, e, lds, bid, nb);
        GemmArgs gc{(const bf16_t*)(ws + O_ACT), DFF, (const bf16_t*)(ws + W_FFOUT), DFF, DFF, 4, 8, 2, 11}; EpiResid ec{p, 0, 5, 0, 1, 0, 0, 0}; gemm_phase(gc, ec, lds, bid, nb); })
    PHASE(10, ln_phase(p, 0, 1, 1, 0, 0, bid, nb, 11, 5, 0, 2, 1);)
    PHASE(11, { GemmArgs ga{(const bf16_t*)(ws + O_H), 1024, (const bf16_t*)(ws + W_MIN), 1024, 1024, RT / 256, 25, 0, 1}; EpiMIn e{p}; gemm_phase(ga, e, lds, bid, nb); })
    PHASE(12, mconv_phase(p, bid, nb);)
    PHASE(13, mlstm_u_phase(p, lds, bid, nb);)
    PHASE(14, mlstm_scan_phase(p, lds, bid, nb);)
    PHASE(15, mlstm_out_phase(p, lds, bid, nb);)
    PHASE(16, { GemmArgs ga{(const bf16_t*)(ws + O_H), 1024, (const bf16_t*)(ws + W_MOUT), 1024, 1024, 128, 8, 1, 1}; EpiResid e{p, 1, 2, 0, 0, 2, 0, 1}; gemm_phase(ga, e, lds, bid, nb); })
    PHASE(17, ln_phase(p, 1, 0, 1, 3, 1, bid, nb, 0, 0, 0, 3);)
    PHASE(18, { GemmArgs ga{(const bf16_t*)(ws + O_H), 1024, (const bf16_t*)(ws + W_FFIN) + (size_t)5632 * 1024, 1024, 1024, 128, 44, 1, 1}; EpiFfIn e{p}; gemm_phase(ga, e, lds, bid, nb); })
    PHASE(19, { GemmArgs ga{(const bf16_t*)(ws + O_ACT), DFF, (const bf16_t*)(ws + W_FFOUT) + (size_t)1024 * 2816, DFF, DFF, 128, 8, 1, 1}; EpiResid e{p, 1, 5, 0, 0, 3, 1, 0}; gemm_phase(ga, e, lds, bid, nb); })
    PHASE(20, ln_phase(p, 1, 1, 1, -1, 1, bid, nb);)
}

extern "C" void kernel_launch(void* const* d_in, const int* in_sizes, int n_in, void* d_out, int out_size, void* d_ws, size_t ws_size, hipStream_t stream) {
    static int grid_blocks = 0;
    if (!grid_blocks) {
        int dev = 0, cus = 0, per_cu = 0;
        hipGetDevice(&dev);
        hipDeviceGetAttribute(&cus, hipDeviceAttributeMultiprocessorCount, dev);
        hipFuncSetAttribute((const void*)fwd_kernel, hipFuncAttributeMaxDynamicSharedMemorySize, LDS_BYTES);
        hipOccupancyMaxActiveBlocksPerMultiprocessor(&per_cu, (const void*)fwd_kernel, NTHR, LDS_BYTES);
        if (per_cu < 1) per_cu = 1;
        if (per_cu > 2) per_cu = 2;
        grid_blocks = cus * per_cu;
        if (ws_size < WS_NEED) fprintf(stderr, "kernel_launch: workspace too small: %zu < %zu\n", ws_size, (size_t)WS_NEED);
    }
    Params p{};
    const float** f = (const float**)&p;
    for (int i = 0; i < 23; ++i) f[i] = (const float*)d_in[i];
    p.out = (float*)d_out; p.ws = (char*)d_ws;
#if !MULTI_LAUNCH
    p.ph_lo = 0; p.ph_hi = NPHASE;
    (void)hipMemsetAsync((char*)d_ws + O_BAR, 0, 16384, stream);
    void* args[] = {&p};
    hipError_t e = hipLaunchCooperativeKernel((const void*)fwd_kernel, dim3(grid_blocks), dim3(NTHR), args, LDS_BYTES, stream);
    if (e != hipSuccess) fprintf(stderr, "cooperative launch failed: %s (grid %d)\n", hipGetErrorString(e), grid_blocks);
#else
    for (int ph = 0; ph < NPHASE; ++ph) {
        p.ph_lo = ph; p.ph_hi = ph + 1;
        hipLaunchKernelGGL(fwd_kernel, dim3(grid_blocks), dim3(NTHR), LDS_BYTES, stream, p);
    }
#endif
}
```

```cpp
#include <hip/hip_runtime.h>
#include <hip/hip_cooperative_groups.h>
#include <cstdio>
#include <cstdint>
namespace cg = cooperative_groups;

#ifndef MULTI_LAUNCH
#define MULTI_LAUNCH 0
#endif

#define DI __device__ __forceinline__
typedef unsigned short bf16_t;
typedef __bf16 bf16v2 __attribute__((ext_vector_type(2)));
typedef float f32x2 __attribute__((ext_vector_type(2)));
typedef short s16x8 __attribute__((ext_vector_type(8)));
typedef short s16x4 __attribute__((ext_vector_type(4)));
typedef float f32x16 __attribute__((ext_vector_type(16)));
typedef float f32x4 __attribute__((ext_vector_type(4)));
typedef unsigned u32x4 __attribute__((ext_vector_type(4)));
typedef unsigned u32x2 __attribute__((ext_vector_type(2)));

constexpr int DM = 1024, NB = 4, SEQ = 8192, CTXL = 256, TT = SEQ + CTXL  , RT = NB * TT  ;
constexpr int DFF = 2816;
constexpr float EPS = 1e-5f;
constexpr float ALPHA = 1.41421356237309515f;
constexpr int NTHR = 256;
constexpr int LDS_BYTES = 77824;

constexpr size_t al256(size_t x) { return (x + 255) & ~(size_t)255; }
constexpr size_t W_ABIN = 0;
constexpr size_t W_UQ = W_ABIN + al256((size_t)2816 * 1024 * 2);
constexpr size_t W_UKV = W_UQ + al256((size_t)768 * 384 * 2);
constexpr size_t W_ABOUT = W_UKV + al256((size_t)1024 * 256 * 2);
constexpr size_t W_FFIN = W_ABOUT + al256((size_t)1024 * 1024 * 2);
constexpr size_t W_FFOUT = W_FFIN + al256((size_t)2 * 5632 * 1024 * 2);
constexpr size_t W_MIN = W_FFOUT + al256((size_t)2 * 1024 * 2816 * 2);
constexpr size_t W_MOUT = W_MIN + al256((size_t)3200 * 1024 * 2);
constexpr size_t O_MODV = W_MOUT + al256((size_t)1024 * 1024 * 2);
constexpr size_t O_TABR = O_MODV + al256((size_t)2 * 5 * 6144 * 4);
constexpr size_t O_TABM = O_TABR + al256((size_t)128 * 32 * 2 * 4);
constexpr size_t O_XCTX = O_TABM + al256((size_t)128 * 8 * 2 * 4);
constexpr size_t O_SSQ = O_XCTX + al256((size_t)1024 * 1024 * 4);
constexpr size_t O_STATS = O_SSQ + al256((size_t)RT * 8 * 4);
constexpr size_t O_H = O_STATS + al256((size_t)3 * RT * 8 * 4);
constexpr size_t O_BAR = O_H + al256((size_t)RT * 1024 * 2);
constexpr size_t O_ARENA = O_BAR + al256((size_t)16384);
constexpr size_t A0_RQ = O_ARENA;
constexpr size_t A0_RK = A0_RQ + al256((size_t)RT * 512 * 2);
constexpr size_t A0_RVT = A0_RK + al256((size_t)RT * 512 * 2);
constexpr size_t A0_RG = A0_RVT + al256((size_t)RT * 512 * 2);
constexpr size_t A0_QB = A0_RG + al256((size_t)RT * 512 * 2);
constexpr size_t A0_KB = A0_QB + al256((size_t)NB * 8 * TT * 96 * 2);
constexpr size_t A0_VT = A0_KB + al256((size_t)NB * 8 * TT * 96 * 2);
constexpr size_t A0_RUS = A0_VT + al256((size_t)NB * 8 * 64 * TT * 2);
constexpr size_t A0_CQ = A0_RUS + al256((size_t)NB * 4 * 2 * 66 * 128 * 128 * 2);
constexpr size_t A0_CKV = A0_CQ + al256((size_t)RT * 384 * 2);
constexpr size_t A0_END = A0_CKV + al256((size_t)RT * 256 * 2);
constexpr size_t O_PART = O_ARENA + (size_t)200 * 1024 * 1024;
constexpr size_t O_ACT = O_ARENA;
constexpr size_t A1_QKPRE = O_ARENA;
constexpr size_t A1_VT = A1_QKPRE + al256((size_t)RT * 1024 * 2);
constexpr size_t A1_OG = A1_VT + al256((size_t)RT * 1024 * 2);
constexpr size_t A1_G = A1_OG + al256((size_t)RT * 1024 * 2);
constexpr size_t A1_U = A1_G + al256((size_t)RT * 32 * 4);
constexpr size_t A1_N = A1_U + al256((size_t)NB * 8 * 2 * 132 * 128 * 64 * 2);
constexpr size_t A1_SC = A1_N + al256((size_t)NB * 8 * 2 * 132 * 64 * 4);
constexpr size_t A1_HALO = A1_SC + al256((size_t)NB * 8 * 2 * 132 * 4 * 4);
constexpr size_t A1_END = A1_HALO + al256((size_t)(RT / 128) * 4 * 1024 * 4);
constexpr size_t WS_NEED = (A0_END > A1_END ? A0_END : A1_END);
static_assert(WS_NEED <= (size_t)536870912, "workspace over 512 MiB");
static_assert(O_ACT + (size_t)RT * 2816 * 2 <= WS_NEED, "act");

struct Params {
    const float *x, *c, *ctx, *c_ctx, *mod_w, *mod_b, *ln_g, *ln_b, *ffn_w_in, *ffn_w_out, *ab_w_in, *q_norm, *w_uq, *kv_norm, *w_ukv,
        *ret_ld, *ab_w_out, *m_w_in, *m_conv_w, *m_conv_b, *m_gate_b, *m_norm_g, *m_w_out;
    float* out; char* ws; int ph_lo, ph_hi;
};

DI unsigned pk(float lo, float hi) { f32x2 v = {lo, hi}; return __builtin_bit_cast(unsigned, __builtin_convertvector(v, bf16v2)); }
DI float bflo(unsigned u) { return __uint_as_float(u << 16); }
DI float bfhi(unsigned u) { return __uint_as_float(u & 0xffff0000u); }
DI bf16_t f2bf(float x) { return (bf16_t)(pk(x, 0.f) & 0xffffu); }
DI float bf2f(bf16_t x) { return __uint_as_float(((unsigned)x) << 16); }
DI int crow(int reg, int h2) { return (reg & 3) + 8 * (reg >> 2) + 4 * h2; }
DI float siluf(float x) { return x * __builtin_amdgcn_rcpf(1.f + __expf(-x)); }
DI float sigmf(float x) { return __builtin_amdgcn_rcpf(1.f + __expf(-x)); }
#define MFMA32(a, b, c) __builtin_amdgcn_mfma_f32_32x32x16_bf16((a), (b), (c), 0, 0, 0)
DI s16x8 pack8(float a0, float a1, float a2, float a3, float a4, float a5, float a6, float a7) {
    u32x4 t = {pk(a0, a1), pk(a2, a3), pk(a4, a5), pk(a6, a7)}; return __builtin_bit_cast(s16x8, t);
}
DI s16x8 cat4(s16x4 lo, s16x4 hi) { return __builtin_shufflevector(lo, hi, 0, 1, 2, 3, 4, 5, 6, 7); }
DI void zero16(f32x16& v) {
#pragma unroll
    for (int i = 0; i < 16; ++i) v[i] = 0.f;
}
DI float* xrow(const Params& p, int g) {
    const int b = g / TT, t = g - b * TT;
    return t < CTXL ? (float*)(p.ws + O_XCTX) + (size_t)(b * CTXL + t) * DM : p.out + (size_t)(b * SEQ + t - CTXL) * DM;
}
DI const float* xrow_in(const Params& p, int g) {
    const int b = g / TT, t = g - b * TT;
    return t < CTXL ? p.ctx + (size_t)(b * CTXL + t) * DM : p.x + (size_t)(b * SEQ + t - CTXL) * DM;
}
DI int modidx(int g) { const int b = g / TT, t = g - b * TT; return t < CTXL ? 4 : b; }

template <class Map>
DI void wconv(const float* src, int K, int Nsrc, int Ndst, bf16_t* dst, const float* rowscale, Map map, int gtid, int gthreads) {
    const int k8n = K >> 3; const long items = (long)Ndst * k8n;
    for (long it = gtid; it < items; it += gthreads) {
        const int n = (int)(it % Ndst), k8 = (int)(it / Ndst);
        const int sn = map(n);
        float v[8];
#pragma unroll
        for (int j = 0; j < 8; ++j) {
            const int k = k8 * 8 + j;
            float x = sn >= 0 ? src[(size_t)k * Nsrc + sn] : 0.f;
            if (rowscale) x *= rowscale[k];
            v[j] = x;
        }
        u32x4 o = {pk(v[0], v[1]), pk(v[2], v[3]), pk(v[4], v[5]), pk(v[6], v[7])};
        *(u32x4*)(dst + (size_t)n * K + k8 * 8) = o;
    }
}
struct MapId { int nsrc; DI int operator()(int n) const { return n < nsrc ? n : -1; } };
struct MapAbIn { DI int operator()(int n) const { return n < 640 ? n : (n < 2688 ? n + 32 : (n < 2720 ? n - 2688 + 640 : -1)); } };
struct MapUq { DI int operator()(int n) const { if (n < 512) return (n >> 6) * 96 + (n & 63); const int m = n - 512; return (m >> 5) * 96 + 64 + (m & 31); } };
struct MapFfIn { DI int operator()(int n) const { const int t = n >> 7, j = n & 127; return j < 64 ? t * 64 + j : 2816 + t * 64 + (j - 64); } };

DI void sincos_acc(float theta, float& c, float& s) {
    const double th = (double)theta;
    const double kq = __builtin_rint(th * 0.63661977236758134308);
    const double r = (th - kq * 1.57079632679489655800) - kq * 6.123233995736766e-17;
    const double r2 = r * r;
    const double sp = r * (1.0 + r2 * (-1.0 / 6 + r2 * (1.0 / 120 + r2 * (-1.0 / 5040 + r2 * (1.0 / 362880 + r2 * (-1.0 / 39916800 + r2 * (1.0 / 6227020800.0)))))));
    const double cp = 1.0 + r2 * (-0.5 + r2 * (1.0 / 24 + r2 * (-1.0 / 720 + r2 * (1.0 / 40320 + r2 * (-1.0 / 3628800 + r2 * (1.0 / 479001600.0 + r2 * (-1.0 / 87178291200.0)))))));
    const int q = ((int)kq) & 3;
    const double cc = (q == 0) ? cp : (q == 1) ? -sp : (q == 2) ? -cp : sp;
    const double ss = (q == 0) ? sp : (q == 1) ? cp : (q == 2) ? -sp : -cp;
    c = (float)cc; s = (float)ss;
}

DI void phase_prologue(const Params& p, char* lds, int bid, int nb) {
    const int tid = threadIdx.x; const int gtid = bid * NTHR + tid, gthreads = nb * NTHR;
    char* ws = p.ws;
    wconv(p.ab_w_in, 1024, 2720, 2816, (bf16_t*)(ws + W_ABIN), nullptr, MapAbIn{}, gtid, gthreads);
    wconv(p.w_uq, 384, 768, 768, (bf16_t*)(ws + W_UQ), p.q_norm, MapUq{}, gtid, gthreads);
    wconv(p.w_ukv, 256, 1024, 1024, (bf16_t*)(ws + W_UKV), p.kv_norm, MapId{1024}, gtid, gthreads);
    wconv(p.ab_w_out, 1024, 1024, 1024, (bf16_t*)(ws + W_ABOUT), nullptr, MapId{1024}, gtid, gthreads);
    for (int l = 0; l < 2; ++l) {
        wconv(p.ffn_w_in + (size_t)l * 1024 * 5632, 1024, 5632, 5632, (bf16_t*)(ws + W_FFIN) + (size_t)l * 5632 * 1024, nullptr, MapFfIn{}, gtid, gthreads);
        wconv(p.ffn_w_out + (size_t)l * 2816 * 1024, 2816, 1024, 1024, (bf16_t*)(ws + W_FFOUT) + (size_t)l * 1024 * 2816, nullptr, MapId{1024}, gtid, gthreads);
    }
    wconv(p.m_w_in, 1024, 3104, 3200, (bf16_t*)(ws + W_MIN), nullptr, MapId{3104}, gtid, gthreads);
    wconv(p.m_w_out, 1024, 1024, 1024, (bf16_t*)(ws + W_MOUT), nullptr, MapId{1024}, gtid, gthreads);
    if (gtid < 128 * 32) {
        const int pos = gtid >> 5, i = gtid & 31;
        const float inv = exp2f(-(float)i * (13.28771237954945f / 32.f));
        float c, s; sincos_acc((float)pos * inv, c, s);
        float* t = (float*)(ws + O_TABR) + (size_t)gtid * 2; t[0] = c; t[1] = s;
    } else if (gtid < 128 * 32 + 128 * 8) {
        const int j = gtid - 128 * 32; const int pos = j >> 3, i = j & 7;
        const float inv = exp2f(-(float)i * (13.28771237954945f / 8.f));
        float c, s; sincos_acc((float)pos * inv, c, s);
        float* t = (float*)(ws + O_TABM) + (size_t)j * 2; t[0] = c; t[1] = s;
    }
    float* sc = (float*)lds;
    float* red = sc + 5 * 1024;
    bool have = false;
    for (int u = bid; u < 2 * 96; u += nb) {
        if (!have) {
            for (int i = tid; i < 5 * 1024; i += NTHR) { const float v = i < 4096 ? p.c[i] : p.c_ctx[i - 4096]; sc[i] = siluf(v); }
            __syncthreads(); have = true;
        }
        const int l = u / 96, nblk = u - l * 96; const int col = nblk * 64 + (tid & 63), kq = tid >> 6;
        const float* w = p.mod_w + (size_t)l * 1024 * 6144 + col;
        float a[5] = {0.f, 0.f, 0.f, 0.f, 0.f};
        for (int k = kq * 256; k < kq * 256 + 256; ++k) {
            const float wv = w[(size_t)k * 6144];
#pragma unroll
            for (int m = 0; m < 5; ++m) a[m] += sc[m * 1024 + k] * wv;
        }
#pragma unroll
        for (int m = 0; m < 5; ++m) red[(kq * 5 + m) * 64 + (tid & 63)] = a[m];
        __syncthreads();
        if (tid < 64) {
            const float bias = p.mod_b[l * 6144 + col];
#pragma unroll
            for (int m = 0; m < 5; ++m) {
                const float s = red[(0 * 5 + m) * 64 + tid] + red[(1 * 5 + m) * 64 + tid] + red[(2 * 5 + m) * 64 + tid] + red[(3 * 5 + m) * 64 + tid];
                ((float*)(ws + O_MODV))[(size_t)(l * 5 + m) * 6144 + col] = s + bias;
            }
        }
        __syncthreads();
    }
}

DI void phase_modulate0(const Params& p, int bid, int nb) {
    const int tid = threadIdx.x; const long gtid = (long)bid * NTHR + tid, gthreads = (long)nb * NTHR;
    const float* modv = (const float*)(p.ws + O_MODV);
    bf16_t* H = (bf16_t*)(p.ws + O_H);
    for (long it = gtid; it < (long)RT * 128; it += gthreads) {
        const int g = (int)(it >> 7), c8 = (int)(it & 127) * 8;
        const float* xr = xrow_in(p, g) + c8; const int mi = modidx(g);
        const float* sh = modv + (size_t)(0 * 5 + mi) * 6144 + 0 * 1024 + c8; const float* sc = sh + 1024;
        const f32x4 a = *(const f32x4*)xr, b = *(const f32x4*)(xr + 4);
        const f32x4 s0 = *(const f32x4*)sh, s1 = *(const f32x4*)(sh + 4), c0 = *(const f32x4*)sc, c1 = *(const f32x4*)(sc + 4);
        const f32x4 y0 = a * (1.f + c0) + s0, y1 = b * (1.f + c1) + s1;
        u32x4 o = {pk(y0[0], y0[1]), pk(y0[2], y0[3]), pk(y1[0], y1[1]), pk(y1[2], y1[3])};
        *(u32x4*)(H + (size_t)g * 1024 + c8) = o;
    }
}

struct GemmArgs { const bf16_t* A; int lda; const bf16_t* Bt; int ldb; int K; int ntm; int ntn; int latonly; int ksplit; };
constexpr int GST = 72;
constexpr int CST = 136;
constexpr int EPI_AUX = 69632;

template <class Epi>
DI void gemm_phase(const GemmArgs& ga, const Epi& epi, char* lds, int bid, int nb) {
    constexpr int KS = 40;
    bf16_t* As = (bf16_t*)lds;
    bf16_t* Bs = As + 2 * 256 * KS;
    float* Cs = (float*)lds;
    const int tid = threadIdx.x, lane = tid & 63, w = tid >> 6, wm = w >> 1, wn = w & 1, l31 = lane & 31, h2 = lane >> 5;
    const int ks_ = ga.ksplit > 1 ? ga.ksplit : 1; const int klen = ga.K / ks_;
    const int ntnv = ga.ntn * ks_;
    const int ntiles = ga.ntm * ntnv, nk = klen >> 5;
    const int xcd = bid & 7, jx = bid >> 3, per = nb >> 3;
    const int nchunk = (ntiles + 63) >> 6;
    const int spc = (64 + per - 1) / per;
    const int lr = tid >> 2, lc = (tid & 3) * 8;
    for (int it = 0;; ++it) {
        const int q = xcd + 8 * (it / spc), tslot = jx + per * (it % spc);
        if (q >= nchunk) break;
        const int tile = q * 64 + tslot;
        if (tslot >= 64 || tile >= ntiles) continue;
        const int grp = tile / (4 * ntnv), rem = tile - grp * 4 * ntnv;
        const int ntv = rem >> 2, mt = grp * 4 + (rem & 3);
        const int part = ntv / ga.ntn, nt = ntv - part * ga.ntn;
        const int g0 = ga.latonly == 1 ? ((mt >> 5) * TT + CTXL + (mt & 31) * 256) : (ga.latonly == 2 ? mt * TT : mt * 256);
        const bf16_t* Ag = ga.A + (size_t)(g0 + lr) * ga.lda + lc + part * klen;
        const bf16_t* Bg = ga.Bt + (size_t)(nt * 128 + lr) * ga.ldb + lc + part * klen;
        const size_t a64 = (size_t)64 * ga.lda, b64 = (size_t)64 * ga.ldb;
        f32x16 acc[4][2];
#pragma unroll
        for (int i = 0; i < 4; ++i)
#pragma unroll
            for (int j = 0; j < 2; ++j) zero16(acc[i][j]);
        u32x4 ra0[4], rb0[2], ra1[4], rb1[2];
#define G_LOAD(RA, RB, K0) { _Pragma("unroll") for (int i = 0; i < 4; ++i) RA[i] = *(const u32x4*)(Ag + i * a64 + (K0)); \
                             _Pragma("unroll") for (int i = 0; i < 2; ++i) RB[i] = *(const u32x4*)(Bg + i * b64 + (K0)); }
#define G_STORE(RA, RB, ST) { bf16_t* Aw = As + (ST) * 256 * KS; bf16_t* Bw = Bs + (ST) * 128 * KS; \
                             _Pragma("unroll") for (int i = 0; i < 4; ++i) *(u32x4*)(Aw + (lr + 64 * i) * KS + lc) = RA[i]; \
                             _Pragma("unroll") for (int i = 0; i < 2; ++i) *(u32x4*)(Bw + (lr + 64 * i) * KS + lc) = RB[i]; }
#define G_COMPUTE_STORE(ST, RA, RB, LA, LB, LK) { const bf16_t* Ac = As + (ST) * 256 * KS + (wm * 128 + l31) * KS + h2 * 8; \
                        const bf16_t* Bc = Bs + (ST) * 128 * KS + (wn * 64 + l31) * KS + h2 * 8; \
                        s16x8 fa0[4], fb0[2], fa1[4], fb1[2]; \
                        _Pragma("unroll") for (int mi = 0; mi < 4; ++mi) fa0[mi] = *(const s16x8*)(Ac + mi * 32 * KS); \
                        fb0[0] = *(const s16x8*)(Bc); fb0[1] = *(const s16x8*)(Bc + 32 * KS); \
                        G_LOAD(LA, LB, LK) \
                        _Pragma("unroll") for (int mi = 0; mi < 4; ++mi) fa1[mi] = *(const s16x8*)(Ac + mi * 32 * KS + 16); \
                        fb1[0] = *(const s16x8*)(Bc + 16); fb1[1] = *(const s16x8*)(Bc + 32 * KS + 16); \
                        _Pragma("unroll") for (int mi = 0; mi < 4; ++mi) { acc[mi][0] = MFMA32(fa0[mi], fb0[0], acc[mi][0]); acc[mi][1] = MFMA32(fa0[mi], fb0[1], acc[mi][1]); } \
                        _Pragma("unroll") for (int mi = 0; mi < 4; ++mi) { acc[mi][0] = MFMA32(fa1[mi], fb1[0], acc[mi][0]); acc[mi][1] = MFMA32(fa1[mi], fb1[1], acc[mi][1]); } \
                        G_STORE(RA, RB, (ST) ^ 1) \
                        __builtin_amdgcn_sched_group_barrier(0x100, 6, 0); \
                        __builtin_amdgcn_sched_group_barrier(0x008, 2, 0); __builtin_amdgcn_sched_group_barrier(0x100, 2, 0); __builtin_amdgcn_sched_group_barrier(0x020, 2, 0); \
                        __builtin_amdgcn_sched_group_barrier(0x008, 2, 0); __builtin_amdgcn_sched_group_barrier(0x100, 2, 0); __builtin_amdgcn_sched_group_barrier(0x020, 2, 0); \
                        __builtin_amdgcn_sched_group_barrier(0x008, 2, 0); __builtin_amdgcn_sched_group_barrier(0x100, 1, 0); __builtin_amdgcn_sched_group_barrier(0x020, 2, 0); \
                        __builtin_amdgcn_sched_group_barrier(0x008, 2, 0); __builtin_amdgcn_sched_group_barrier(0x100, 1, 0); \
                        __builtin_amdgcn_sched_group_barrier(0x008, 2, 0); __builtin_amdgcn_sched_group_barrier(0x200, 2, 0); \
                        __builtin_amdgcn_sched_group_barrier(0x008, 2, 0); __builtin_amdgcn_sched_group_barrier(0x200, 2, 0); \
                        __builtin_amdgcn_sched_group_barrier(0x008, 2, 0); __builtin_amdgcn_sched_group_barrier(0x200, 2, 0); \
                        __builtin_amdgcn_sched_group_barrier(0x008, 2, 0); \
                        __builtin_amdgcn_sched_barrier(0); }
        G_LOAD(ra0, rb0, 0)
        G_STORE(ra0, rb0, 0)
        G_LOAD(ra0, rb0, 32)
        __syncthreads();
        for (int kt = 0; kt < nk; kt += 2) {
            { const int kk = (kt + 2 < nk ? kt + 2 : nk - 1) * 32;
              G_COMPUTE_STORE(0, ra0, rb0, ra1, rb1, kk) }
            __syncthreads();
            { const int kk = (kt + 3 < nk ? kt + 3 : nk - 1) * 32;
              G_COMPUTE_STORE(1, ra1, rb1, ra0, rb0, kk) }
            __syncthreads();
        }
#undef G_LOAD
#undef G_STORE
#undef G_COMPUTE_STORE
#pragma unroll
        for (int hh = 0; hh < 2; ++hh) {
            if (wm == hh) {
#pragma unroll
                for (int mi = 0; mi < 4; ++mi)
#pragma unroll
                    for (int ni = 0; ni < 2; ++ni)
#pragma unroll
                        for (int r = 0; r < 16; ++r) Cs[(mi * 32 + crow(r, h2)) * CST + wn * 64 + ni * 32 + l31] = acc[mi][ni][r];
            }
            __syncthreads();
            epi(Cs, lds, g0 + hh * 128, nt + ga.ntn * part);
            __syncthreads();
        }
    }
}

template <int NCOLS>
DI void twrite(const float* Cs, int c_lo, bf16_t* dst, size_t ld, const float* rowscale) {
    constexpr int TPC = 256 / NCOLS, RPT = 128 / TPC;
    int tid = threadIdx.x; asm volatile("" : "+v"(tid)); const int c = tid % NCOLS, part = tid / NCOLS;
    const float* src = Cs + c_lo + c;
    bf16_t* d = dst + (size_t)c * ld + part * RPT;
#pragma unroll 2
    for (int j = 0; j < RPT / 8; ++j) {
        float v[8];
#pragma unroll
        for (int e = 0; e < 8; ++e) { const int row = part * RPT + j * 8 + e; float x = src[row * CST]; if (rowscale) x *= rowscale[row]; v[e] = x; }
        u32x4 o = {pk(v[0], v[1]), pk(v[2], v[3]), pk(v[4], v[5]), pk(v[6], v[7])};
        *(u32x4*)(d + j * 8) = o;
    }
}

DI f32x4 rope4(f32x4 v, f32x4 pv, const float* tab, bool second) {
    const f32x4 t0 = *(const f32x4*)tab, t1 = *(const f32x4*)(tab + 4);
    const f32x4 cs = {t0[0], t0[2], t1[0], t1[2]}, sn = {t0[1], t0[3], t1[1], t1[3]};
    return second ? pv * sn + v * cs : v * cs - pv * sn;
}

struct EpiAbIn {
    Params p;
    DI void operator()(const float* Cs, char* lds, int g0, int nt) const {
        int tid = threadIdx.x; asm volatile("" : "+v"(tid)); const int lane = tid & 63, w = tid >> 6, l31 = lane & 31, h2 = lane >> 5;
        const int b = g0 / TT, t0 = g0 - b * TT; const bool lat = t0 >= CTXL; const int c = 4 * l31;
        char* ws = p.ws;
        if (nt < 5) {
            bf16_t* dst = nt < 3 ? (bf16_t*)(ws + A0_CQ) + (size_t)g0 * 384 + nt * 128 : (bf16_t*)(ws + A0_CKV) + (size_t)g0 * 256 + (nt - 3) * 128;
            const int ld = nt < 3 ? 384 : 256;
            float* ssq = (float*)(ws + O_SSQ);
#pragma unroll 1
            for (int i = 0; i < 16; ++i) {
                const int row = w * 32 + 2 * i + h2;
                const f32x4 v = *(const f32x4*)(Cs + row * CST + c);
                float ss = v[0] * v[0] + v[1] * v[1] + v[2] * v[2] + v[3] * v[3];
                ss += __shfl_xor(ss, 1); ss += __shfl_xor(ss, 2); ss += __shfl_xor(ss, 4); ss += __shfl_xor(ss, 8); ss += __shfl_xor(ss, 16);
                u32x2 o = {pk(v[0], v[1]), pk(v[2], v[3])};
                *(u32x2*)(dst + (size_t)row * ld + c) = o;
                if (l31 == 0) ssq[(size_t)(g0 + row) * 8 + nt] = ss;
            }
        } else if (nt < 13) {
            const bool isk = nt >= 9; const int hh = (nt - 5) & 3;
            bf16_t* dst = (bf16_t*)(ws + (isk ? A0_RK : A0_RQ)) + (size_t)g0 * 512 + hh * 128;
            const float scl = isk ? 0.08838834764831845f : 1.f;
            const float* tab = (const float*)(ws + O_TABR);
#pragma unroll 1
            for (int i = 0; i < 16; ++i) {
                const int row = w * 32 + 2 * i + h2;
                f32x4 v = *(const f32x4*)(Cs + row * CST + c);
                if (lat) {
                    const f32x4 pv = *(const f32x4*)(Cs + row * CST + (c ^ 32));
                    const int s = t0 + row - CTXL; const int pos = c < 64 ? (s >> 6) : (s & 63);
                    v = rope4(v, pv, tab + (size_t)(pos * 32 + (c & 31)) * 2, (c & 32) != 0);
                }
                v = v * scl;
                u32x2 o = {pk(v[0], v[1]), pk(v[2], v[3])};
                *(u32x2*)(dst + (size_t)row * 512 + c) = o;
            }
        } else if (nt < 17) {
            const int hh = nt - 13;
            twrite<128>(Cs, 0, (bf16_t*)(ws + A0_RVT) + ((size_t)(b * 4 + hh) * 128) * TT + t0, TT, nullptr);
        } else if (nt < 21) {
            bf16_t* dst = (bf16_t*)(ws + A0_RG) + (size_t)g0 * 512 + (nt - 17) * 128;
#pragma unroll 1
            for (int i = 0; i < 16; ++i) {
                const int row = w * 32 + 2 * i + h2;
                const f32x4 v = *(const f32x4*)(Cs + row * CST + c);
                u32x2 o = {pk(v[0], v[1]), pk(v[2], v[3])};
                *(u32x2*)(dst + (size_t)row * 512 + c) = o;
            }
        } else {
            const float* tab = (const float*)(ws + O_TABM);
            bf16_t* kb = (bf16_t*)(ws + A0_KB);
            if (l31 < 8) {
#pragma unroll 1
                for (int i = 0; i < 16; ++i) {
                    const int row = w * 32 + 2 * i + h2;
                    f32x4 v = *(const f32x4*)(Cs + row * CST + c);
                    if (lat) {
                        const f32x4 pv = *(const f32x4*)(Cs + row * CST + (c ^ 8));
                        const int s = t0 + row - CTXL; const int pos = c < 16 ? (s >> 6) : (s & 63);
                        v = rope4(v, pv, tab + (size_t)(pos * 8 + (c & 7)) * 2, (c & 8) != 0);
                    }
                    u32x2 o = {pk(v[0], v[1]), pk(v[2], v[3])};
#pragma unroll
                    for (int h = 0; h < 8; ++h) *(u32x2*)(kb + ((size_t)(b * 8 + h) * TT + t0 + row) * 96 + 64 + c) = o;
                }
            }
        }
    }
};

struct EpiUq {
    Params p;
    DI void operator()(const float* Cs, char* lds, int g0, int nt) const {
        int tid = threadIdx.x; asm volatile("" : "+v"(tid)); const int lane = tid & 63, w = tid >> 6, l31 = lane & 31, h2 = lane >> 5;
        const int b = g0 / TT, t0 = g0 - b * TT; const bool lat = t0 >= CTXL; const int c = 4 * l31;
        char* ws = p.ws;
        const float* ssq = (const float*)(ws + O_SSQ);
        bf16_t* qb = (bf16_t*)(ws + A0_QB);
        const float* tab = (const float*)(ws + O_TABM);
        const float qscale = 0.10206207261596575f * 1.4426950408889634f;
#pragma unroll 1
        for (int i = 0; i < 16; ++i) {
            const int row = w * 32 + 2 * i + h2; const int g = g0 + row;
            const float rs = rsqrtf((ssq[(size_t)g * 8] + ssq[(size_t)g * 8 + 1] + ssq[(size_t)g * 8 + 2]) * (1.f / 384.f) + EPS) * qscale;
            f32x4 v = *(const f32x4*)(Cs + row * CST + c);
            int head, j;
            if (nt < 4) { head = nt * 2 + (c >> 6); j = c & 63; }
            else {
                head = (nt - 4) * 4 + (c >> 5); const int jj = c & 31; j = 64 + jj;
                if (lat) {
                    const f32x4 pv = *(const f32x4*)(Cs + row * CST + (c ^ 8));
                    const int s = t0 + row - CTXL; const int pos = jj < 16 ? (s >> 6) : (s & 63);
                    v = rope4(v, pv, tab + (size_t)(pos * 8 + (jj & 7)) * 2, (jj & 8) != 0);
                }
            }
            v = v * rs;
            u32x2 o = {pk(v[0], v[1]), pk(v[2], v[3])};
            *(u32x2*)(qb + ((size_t)(b * 8 + head) * TT + t0 + row) * 96 + j) = o;
        }
    }
};

struct EpiUkv {
    Params p;
    DI void operator()(const float* Cs, char* lds, int g0, int nt) const {
        int tid = threadIdx.x; asm volatile("" : "+v"(tid)); const int lane = tid & 63, w = tid >> 6, l31 = lane & 31, h2 = lane >> 5;
        const int b = g0 / TT, t0 = g0 - b * TT; const int c = 4 * l31;
        char* ws = p.ws;
        const float* ssq = (const float*)(ws + O_SSQ);
        float* rsl = (float*)(lds + EPI_AUX);
        if (tid < 128) { const int g = g0 + tid; rsl[tid] = rsqrtf((ssq[(size_t)g * 8 + 3] + ssq[(size_t)g * 8 + 4]) * (1.f / 256.f) + EPS); }
        __syncthreads();
        bf16_t* kb = (bf16_t*)(ws + A0_KB);
        if (l31 < 16) {
#pragma unroll 1
            for (int i = 0; i < 16; ++i) {
                const int row = w * 32 + 2 * i + h2;
                f32x4 v = *(const f32x4*)(Cs + row * CST + c); v = v * rsl[row];
                u32x2 o = {pk(v[0], v[1]), pk(v[2], v[3])};
                *(u32x2*)(kb + ((size_t)(b * 8 + nt) * TT + t0 + row) * 96 + c) = o;
            }
        }
        twrite<64>(Cs, 64, (bf16_t*)(ws + A0_VT) + ((size_t)(b * 8 + nt) * 64) * TT + t0, TT, rsl);
    }
};

struct EpiResid {
    Params p; int layer, gate_chunk, from_input, partial, lazy, lnl, lnw;
    DI void operator()(const float* Cs, char* lds, int g0, int ntv) const {
        int tid = threadIdx.x; asm volatile("" : "+v"(tid)); const int lane = tid & 63, w = tid >> 6, l31 = lane & 31, h2 = lane >> 5;
        const int c = 4 * l31;
        if (partial) {
            const int part = ntv >> 3, nt = ntv & 7;
            const int b = g0 / TT, t0 = g0 - b * TT;
            float* dst = (float*)(p.ws + O_PART) + ((size_t)part * 1024 + b * CTXL + t0) * DM + nt * 128 + c;
#pragma unroll 4
            for (int i = 0; i < 16; ++i) { const int row = w * 32 + 2 * i + h2; *(f32x4*)(dst + (size_t)row * DM) = *(const f32x4*)(Cs + row * CST + c); }
            return;
        }
        const int nt = ntv; const int mi = modidx(g0);
        const float* gate = (const float*)(p.ws + O_MODV) + (size_t)(layer * 5 + mi) * 6144 + gate_chunk * 1024 + nt * 128 + c;
        const f32x4 gv = *(const f32x4*)gate;
        f32x4 lgv = {1.f, 1.f, 1.f, 1.f}, lbv = {0.f, 0.f, 0.f, 0.f};
        const float* st = (const float*)(p.ws + O_STATS) + (size_t)(lazy > 0 ? lazy - 1 : 0) * RT * 8;
        if (lazy > 0) { lgv = *(const f32x4*)(p.ln_g + (size_t)(lnl * 2 + lnw) * 1024 + nt * 128 + c); lbv = *(const f32x4*)(p.ln_b + (size_t)(lnl * 2 + lnw) * 1024 + nt * 128 + c); }
#pragma unroll 4
        for (int i = 0; i < 16; ++i) {
            const int row = w * 32 + 2 * i + h2; const int g = g0 + row;
            const f32x4 v = *(const f32x4*)(Cs + row * CST + c);
            float* xd = xrow(p, g) + nt * 128 + c;
            const float* xs = from_input ? xrow_in(p, g) + nt * 128 + c : xd;
            f32x4 xv = *(const f32x4*)xs;
            if (lazy > 0) { const float mu = __hip_atomic_load(st + (size_t)g * 8, __ATOMIC_RELAXED, __HIP_MEMORY_SCOPE_AGENT), rs = __hip_atomic_load(st + (size_t)g * 8 + 1, __ATOMIC_RELAXED, __HIP_MEMORY_SCOPE_AGENT); xv = (xv - mu) * rs * lgv + lbv; }
            *(f32x4*)xd = xv * ALPHA + gv * v;
        }
    }
};

struct EpiFfIn {
    Params p;
    DI void operator()(const float* Cs, char* lds, int g0, int nt) const {
        int tid = threadIdx.x; asm volatile("" : "+v"(tid)); const int lane = tid & 63, w = tid >> 6;
        const int c = 4 * (lane & 15);
        bf16_t* act = (bf16_t*)(p.ws + O_ACT);
#pragma unroll 4
        for (int i = 0; i < 8; ++i) {
            const int row = w * 32 + i * 4 + (lane >> 4);
            const f32x4 up = *(const f32x4*)(Cs + row * CST + c), gt = *(const f32x4*)(Cs + row * CST + 64 + c);
            u32x2 o = {pk(siluf(gt[0]) * up[0], siluf(gt[1]) * up[1]), pk(siluf(gt[2]) * up[2], siluf(gt[3]) * up[3])};
            *(u32x2*)(act + (size_t)(g0 + row) * DFF + nt * 64 + c) = o;
        }
    }
};

DI float logsigmoidf(float x) { return fminf(x, 0.f) - __logf(1.f + __expf(-fabsf(x))); }

struct EpiMIn {
    static constexpr bool PREFETCH = false;
    Params p;
    DI void operator()(const float* Cs, char* lds, int g0, int nt) const {
        int tid = threadIdx.x; asm volatile("" : "+v"(tid)); const int lane = tid & 63, w = tid >> 6, l31 = lane & 31, h2 = lane >> 5;
        const int b = g0 / TT, t0 = g0 - b * TT; const int c = 4 * l31;
        char* ws = p.ws;
        if (nt < 8) {
            const int ch = nt * 128 + c;
            bf16_t* dst = (bf16_t*)(ws + A1_QKPRE) + (size_t)g0 * 1024 + ch;
            float* halo = (float*)(ws + A1_HALO) + (size_t)(g0 >> 7) * 4 * 1024 + ch;
            const f32x4 w0 = *(const f32x4*)(p.m_conv_w + ch), w1 = *(const f32x4*)(p.m_conv_w + 1024 + ch), w2 = *(const f32x4*)(p.m_conv_w + 2048 + ch), bb = *(const f32x4*)(p.m_conv_b + ch);
            const float scl = nt >= 4 ? 0.125f : 1.f;
#pragma unroll 1
            for (int i = 0; i < 16; ++i) {
                const int row = w * 32 + 2 * i + h2;
                const f32x4 x0 = *(const f32x4*)(Cs + row * CST + c);
                if (row == 0 || row == 1 || row == 126 || row == 127) *(f32x4*)(halo + (size_t)(row < 2 ? row : row - 124) * 1024) = x0;
                if (row >= 1 && row <= 126) {
                    const f32x4 xm = *(const f32x4*)(Cs + (row - 1) * CST + c), xp = *(const f32x4*)(Cs + (row + 1) * CST + c);
                    const f32x4 a = xm * w0 + x0 * w1 + xp * w2 + bb;
                    u32x2 o = {pk(siluf(a[0]) * scl, siluf(a[1]) * scl), pk(siluf(a[2]) * scl, siluf(a[3]) * scl)};
                    *(u32x2*)(dst + (size_t)row * 1024) = o;
                }
            }
        } else if (nt >= 16 && nt < 24) {
            bf16_t* dst = (bf16_t*)(ws + A1_OG) + (size_t)g0 * 1024 + (nt - 16) * 128;
#pragma unroll 1
            for (int i = 0; i < 16; ++i) {
                const int row = w * 32 + 2 * i + h2;
                const f32x4 v = *(const f32x4*)(Cs + row * CST + c);
                u32x2 o = {pk(v[0], v[1]), pk(v[2], v[3])};
                *(u32x2*)(dst + (size_t)row * 1024 + c) = o;
            }
        } else if (nt < 16) {
            twrite<128>(Cs, 0, (bf16_t*)(ws + A1_VT) + ((size_t)(b * 8 + (nt - 8)) * 128) * TT + t0, TT, nullptr);
        } else {
            float* mg = (float*)(ws + A1_G);
            if (l31 < 8) {
                const f32x4 gb = *(const f32x4*)(p.m_gate_b + c);
                const bool ls = ((c >> 3) & 1) != 0;
#pragma unroll 1
                for (int i = 0; i < 16; ++i) {
                    const int row = w * 32 + 2 * i + h2;
                    f32x4 v = *(const f32x4*)(Cs + row * CST + c); v = v + gb;
                    if (ls) { v[0] = logsigmoidf(v[0]); v[1] = logsigmoidf(v[1]); v[2] = logsigmoidf(v[2]); v[3] = logsigmoidf(v[3]); }
                    *(f32x4*)(mg + (size_t)(g0 + row) * 32 + c) = v;
                }
            }
        }
    }
};

DI f32x4 ld_nt(const float* q) { return __builtin_nontemporal_load((const f32x4*)q); }
DI void ln_phase(const Params& p, int layer, int which, int next_layer, int next_chunk  , int latonly, int bid, int nb, int nparts = 0, int gate_chunk = 0, int from_input = 0, int lazy_out = 0  , int lazy_src = 0  ) {
    const int tid = threadIdx.x, lane = tid & 63;
    const float* lg = p.ln_g + (size_t)(layer * 2 + which) * 1024; const float* lb = p.ln_b + (size_t)(layer * 2 + which) * 1024;
    const float* modv = (const float*)(p.ws + O_MODV);
    bf16_t* H = (bf16_t*)(p.ws + O_H);
    const int nrows = latonly ? NB * SEQ : RT;
    f32x4 gv[4], bv[4];
#pragma unroll
    for (int i = 0; i < 4; ++i) { gv[i] = *(const f32x4*)(lg + i * 256 + lane * 4); bv[i] = *(const f32x4*)(lb + i * 256 + lane * 4); }
    for (int r = bid * 4 + (tid >> 6); r < nrows; r += nb * 4) {
        const int g = latonly ? ((r >> 13) * TT + CTXL + (r & 8191)) : r;
        float* xr = xrow(p, g);
        f32x4 v[4]; float s = 0.f;
        const int tloc = g % TT;
        const bool assembled = nparts > 0 && tloc < CTXL;
        if (nparts > 0 && tloc < CTXL) {
            const float* xs = from_input ? xrow_in(p, g) : xr;
            const float* gate = modv + (size_t)(layer * 5 + 4) * 6144 + gate_chunk * 1024;
            const float* pp = (const float*)(p.ws + O_PART) + (size_t)((g / TT) * CTXL + tloc) * DM;
#pragma unroll
            for (int i = 0; i < 4; ++i) {
                f32x4 acc = *(const f32x4*)(pp + i * 256 + lane * 4);
                for (int q = 1; q < nparts; ++q) acc = acc + *(const f32x4*)(pp + (size_t)q * 1024 * DM + i * 256 + lane * 4);
                f32x4 xv = *(const f32x4*)(xs + i * 256 + lane * 4);
                if (lazy_src > 0) {
                    const float* st = (const float*)(p.ws + O_STATS) + (size_t)(lazy_src - 1) * RT * 8 + (size_t)g * 8;
                    const float mu0 = __hip_atomic_load(st, __ATOMIC_RELAXED, __HIP_MEMORY_SCOPE_AGENT), rs0 = __hip_atomic_load(st + 1, __ATOMIC_RELAXED, __HIP_MEMORY_SCOPE_AGENT);
                    const f32x4 g4 = *(const f32x4*)(p.ln_g + (size_t)(layer * 2 + 0) * 1024 + i * 256 + lane * 4), b4 = *(const f32x4*)(p.ln_b + (size_t)(layer * 2 + 0) * 1024 + i * 256 + lane * 4);
                    xv = (xv - mu0) * rs0 * g4 + b4;
                }
                v[i] = xv * ALPHA + *(const f32x4*)(gate + i * 256 + lane * 4) * acc;
            }
        } else {
#pragma unroll
            for (int i = 0; i < 4; ++i) v[i] = ld_nt(xr + i * 256 + lane * 4);
        }
#pragma unroll
        for (int i = 0; i < 4; ++i) s += (v[i][0] + v[i][1]) + (v[i][2] + v[i][3]);
#pragma unroll
        for (int o = 1; o < 64; o <<= 1) s += __shfl_xor(s, o);
        const float mu = s * (1.f / 1024.f); float q = 0.f;
#pragma unroll
        for (int i = 0; i < 4; ++i) { v[i] = v[i] - mu; q += (v[i][0] * v[i][0] + v[i][1] * v[i][1]) + (v[i][2] * v[i][2] + v[i][3] * v[i][3]); }
#pragma unroll
        for (int o = 1; o < 64; o <<= 1) q += __shfl_xor(q, o);
        const float rstd = rsqrtf(q * (1.f / 1024.f) + EPS);
        if (lazy_out > 0 && lane == 0) { float* st = (float*)(p.ws + O_STATS) + (size_t)(lazy_out - 1) * RT * 8 + (size_t)g * 8; __hip_atomic_store(st, mu, __ATOMIC_RELAXED, __HIP_MEMORY_SCOPE_AGENT); __hip_atomic_store(st + 1, rstd, __ATOMIC_RELAXED, __HIP_MEMORY_SCOPE_AGENT); }
        const int mi = modidx(g);
        const float* sh = modv + (size_t)(next_layer * 5 + mi) * 6144 + (next_chunk < 0 ? 0 : next_chunk) * 1024; const float* sc = sh + 1024;
#pragma unroll
        for (int i = 0; i < 4; ++i) {
            const f32x4 y = v[i] * rstd * gv[i] + bv[i];
            if (lazy_out == 0) *(f32x4*)(xr + i * 256 + lane * 4) = y;
            else if (assembled) *(f32x4*)(xr + i * 256 + lane * 4) = v[i] + mu;
            if (next_chunk >= 0) {
                const f32x4 s4 = *(const f32x4*)(sh + i * 256 + lane * 4), c4 = *(const f32x4*)(sc + i * 256 + lane * 4);
                const f32x4 h = y * (1.f + c4) + s4;
                u32x2 o = {pk(h[0], h[1]), pk(h[2], h[3])};
                *(u32x2*)(H + (size_t)g * 1024 + i * 256 + lane * 4) = o;
            }
        }
    }
}

DI void attn_softmax(f32x16 (&s)[2], float& m, float& l, f32x16 (&o)[2]) {
    float mx = fmaxf(s[0][0], s[1][0]);
#pragma unroll
    for (int r = 1; r < 16; ++r) mx = fmaxf(mx, fmaxf(s[0][r], s[1][r]));
    if (__builtin_amdgcn_ballot_w64(mx > m + 8.f) != 0ull) {
        mx = fmaxf(mx, __shfl_xor(mx, 32));
        const float mn = fmaxf(m, mx); const float alpha = __builtin_amdgcn_exp2f(m - mn); m = mn;
        l *= alpha;
#pragma unroll
        for (int r = 0; r < 16; ++r) { o[0][r] *= alpha; o[1][r] *= alpha; }
    }
    float ps = 0.f;
#pragma unroll
    for (int r = 0; r < 16; ++r) { s[0][r] = __builtin_amdgcn_exp2f(s[0][r] - m); s[1][r] = __builtin_amdgcn_exp2f(s[1][r] - m); ps += s[0][r] + s[1][r]; }
    l += ps;
}
DI void attn_pack(const f32x16 (&s)[2], s16x8 (&pf)[4]) {
#pragma unroll
    for (int kb = 0; kb < 2; ++kb)
#pragma unroll
        for (int sp = 0; sp < 2; ++sp)
            pf[kb * 2 + sp] = pack8(s[kb][8 * sp], s[kb][8 * sp + 1], s[kb][8 * sp + 2], s[kb][8 * sp + 3], s[kb][8 * sp + 4], s[kb][8 * sp + 5], s[kb][8 * sp + 6], s[kb][8 * sp + 7]);
}
DI void attn_pv(const s16x8 (&pf)[4], f32x16 (&o)[2], const bf16_t* Vc, int VST) {
#pragma unroll
    for (int kk = 0; kk < 4; ++kk) {
        const int ko = kk * 16;
#pragma unroll
        for (int vb = 0; vb < 2; ++vb) {
            const s16x4 lo = *(const s16x4*)(Vc + vb * 32 * VST + ko), hi = *(const s16x4*)(Vc + vb * 32 * VST + ko + 8);
            o[vb] = MFMA32(cat4(lo, hi), pf[kk], o[vb]);
        }
    }
}
DI void attn_sm2(f32x16 (&s)[2], float& m, float& l, f32x16 (&o)[2], s16x8 (&pf)[4]) {
    constexpr float THR = 4.f;
    float mx = s[0][0];
#pragma unroll
    for (int r = 0; r < 16; ++r) { mx = fmaxf(mx, s[0][r]); mx = fmaxf(mx, s[1][r]); }
    mx = fmaxf(mx, __shfl_xor(mx, 32));
    if (__builtin_amdgcn_ballot_w64(mx > m + THR) != 0ull) {
        const float mn = fmaxf(m, mx); const float alpha = __builtin_amdgcn_exp2f(m - mn); m = mn;
        l *= alpha;
#pragma unroll
        for (int r = 0; r < 16; ++r) { o[0][r] *= alpha; o[1][r] *= alpha; }
    }
    float ps = 0.f;
#pragma unroll
    for (int r = 0; r < 16; ++r) { s[0][r] = __builtin_amdgcn_exp2f(s[0][r] - m); s[1][r] = __builtin_amdgcn_exp2f(s[1][r] - m); ps += s[0][r] + s[1][r]; }
    l += ps;
#pragma unroll
    for (int kb = 0; kb < 2; ++kb)
#pragma unroll
        for (int sp = 0; sp < 2; ++sp)
            pf[kb * 2 + sp] = pack8(s[kb][8 * sp], s[kb][8 * sp + 1], s[kb][8 * sp + 2], s[kb][8 * sp + 3], s[kb][8 * sp + 4], s[kb][8 * sp + 5], s[kb][8 * sp + 6], s[kb][8 * sp + 7]);
}
DI void attn_pv2(const s16x8 (&pf)[4], f32x16 (&o)[2], const bf16_t* Vc, int VST) {
#pragma unroll
    for (int kk = 0; kk < 4; ++kk)
#pragma unroll
        for (int vb = 0; vb < 2; ++vb) {
            const s16x4 lo = *(const s16x4*)(Vc + vb * 32 * VST + kk * 16), hi = *(const s16x4*)(Vc + vb * 32 * VST + kk * 16 + 8);
            o[vb] = MFMA32(cat4(lo, hi), pf[kk], o[vb]);
        }
}
DI void attn_phase(const Params& p, char* lds, int bid, int nb) {
    constexpr int KST = 104, VST = 68;
    bf16_t* Ks = (bf16_t*)lds;
    bf16_t* Vs = Ks + 2 * 64 * KST;
    bf16_t* Qs = Vs + 2 * 64 * VST;
    const int tid = threadIdx.x, lane = tid & 63, w = tid >> 6, l31 = lane & 31, h2 = lane >> 5;
    char* ws = p.ws;
    const bf16_t* QB = (const bf16_t*)(ws + A0_QB); const bf16_t* KB = (const bf16_t*)(ws + A0_KB); const bf16_t* VT = (const bf16_t*)(ws + A0_VT);
    bf16_t* MIX = (bf16_t*)(ws + O_H);
    const int xcd = bid & 7, j = bid >> 3, per = nb >> 3;
    const int nlat = 128;
    for (int uu = j; uu < nlat + 4; uu += per) {
        int b, h, q0, nkt;
        if (uu < nlat) { const int bh = xcd + 8 * (uu >> 5); b = bh >> 3; h = bh & 7; q0 = CTXL + (uu & 31) * 256; nkt = TT / 64; }
        else { const int bh = xcd + 8 * (uu - nlat); b = bh >> 3; h = bh & 7; q0 = 0; nkt = CTXL / 64; }
        const size_t bh_ = (size_t)(b * 8 + h);
        const bf16_t* Qg = QB + (bh_ * TT + q0 + w * 64 + l31) * 96 + h2 * 8;
        s16x8 qfA[6];
        bf16_t* Qb = Qs + (w * 32 + l31) * KST + h2 * 8;
#pragma unroll
        for (int ks = 0; ks < 6; ++ks) { qfA[ks] = *(const s16x8*)(Qg + ks * 16); *(s16x8*)(Qb + ks * 16) = *(const s16x8*)(Qg + 32 * 96 + ks * 16); }
        const bf16_t* Kg = KB + bh_ * TT * 96;
        const bf16_t* Vg = VT + bh_ * 64 * TT;
        f32x16 oA[2], oB[2]; zero16(oA[0]); zero16(oA[1]); zero16(oB[0]); zero16(oB[1]);
        float mA = -1e30f, lA = 0.f, mB = -1e30f, lB = 0.f;
        u32x4 rk[3], rv[2];
#pragma unroll
        for (int i = 0; i < 3; ++i) { const int idx = tid + 256 * i; rk[i] = *(const u32x4*)(Kg + (size_t)idx * 8); }
#pragma unroll
        for (int i = 0; i < 2; ++i) { const int idx = tid + 256 * i, r = idx >> 3, c8 = idx & 7; rv[i] = *(const u32x4*)(Vg + (size_t)r * TT + c8 * 8); }
#pragma unroll
        for (int i = 0; i < 3; ++i) { const int idx = tid + 256 * i, r = idx / 12, c8 = idx - r * 12; *(u32x4*)(Ks + r * KST + c8 * 8) = rk[i]; }
#pragma unroll
        for (int i = 0; i < 2; ++i) { const int idx = tid + 256 * i, r = idx >> 3, c8 = idx & 7;
            u32x2 a = {rv[i][0], rv[i][1]}, bq = {rv[i][2], rv[i][3]};
            *(u32x2*)(Vs + r * VST + c8 * 8) = a; *(u32x2*)(Vs + r * VST + c8 * 8 + 4) = bq; }
        __syncthreads();
#pragma unroll 1
        for (int kt = 0; kt < nkt; ++kt) {
            const int cur = kt & 1;
            {
                const int kn = kt + 1 < nkt ? kt + 1 : kt;
                const bf16_t* Kn = Kg + (size_t)kn * 64 * 96; const bf16_t* Vn = Vg + kn * 64;
#pragma unroll
                for (int i = 0; i < 3; ++i) { const int idx = tid + 256 * i; rk[i] = *(const u32x4*)(Kn + (size_t)idx * 8); }
#pragma unroll
                for (int i = 0; i < 2; ++i) { const int idx = tid + 256 * i, r = idx >> 3, c8 = idx & 7; rv[i] = *(const u32x4*)(Vn + (size_t)r * TT + c8 * 8); }
            }
            const bf16_t* Kc = Ks + cur * 64 * KST + l31 * KST + h2 * 8;
            const bf16_t* Vc = Vs + cur * 64 * VST + l31 * VST + 4 * h2;
            s16x8 pfA[4], pfB[4];
            {
                f32x16 sA[2]; zero16(sA[0]); zero16(sA[1]);
#pragma unroll
                for (int ks = 0; ks < 6; ++ks) {
                    const s16x8 a0 = *(const s16x8*)(Kc + ks * 16), a1 = *(const s16x8*)(Kc + 32 * KST + ks * 16);
                    sA[0] = MFMA32(a0, qfA[ks], sA[0]); sA[1] = MFMA32(a1, qfA[ks], sA[1]);
                }
                attn_sm2(sA, mA, lA, oA, pfA);
            }
            __builtin_amdgcn_sched_barrier(0);
            {
                f32x16 sB[2]; zero16(sB[0]); zero16(sB[1]);
#pragma unroll 2
                for (int ks = 0; ks < 6; ++ks) {
                    const s16x8 a0 = *(const s16x8*)(Kc + ks * 16), a1 = *(const s16x8*)(Kc + 32 * KST + ks * 16);
                    const s16x8 qb = *(const s16x8*)(Qb + ks * 16);
                    sB[0] = MFMA32(a0, qb, sB[0]); sB[1] = MFMA32(a1, qb, sB[1]);
                }
                attn_pv2(pfA, oA, Vc, VST);
                attn_sm2(sB, mB, lB, oB, pfB);
            }
            __builtin_amdgcn_sched_barrier(0);
            attn_pv2(pfB, oB, Vc, VST);
            {
                bf16_t* Kw = Ks + (cur ^ 1) * 64 * KST; bf16_t* Vw = Vs + (cur ^ 1) * 64 * VST;
#pragma unroll
                for (int i = 0; i < 3; ++i) { const int idx = tid + 256 * i, r = idx / 12, c8 = idx - r * 12; *(u32x4*)(Kw + r * KST + c8 * 8) = rk[i]; }
#pragma unroll
                for (int i = 0; i < 2; ++i) { const int idx = tid + 256 * i, r = idx >> 3, c8 = idx & 7;
                    u32x2 a = {rv[i][0], rv[i][1]}, bq = {rv[i][2], rv[i][3]};
                    *(u32x2*)(Vw + r * VST + c8 * 8) = a; *(u32x2*)(Vw + r * VST + c8 * 8 + 4) = bq; }
            }
            __syncthreads();
        }
        lA += __shfl_xor(lA, 32); lB += __shfl_xor(lB, 32);
        const float invA = __builtin_amdgcn_rcpf(lA), invB = __builtin_amdgcn_rcpf(lB);
        bf16_t* dst = MIX + ((size_t)b * TT + q0 + w * 64 + l31) * 1024 + h * 64 + 4 * h2;
#pragma unroll
        for (int vb = 0; vb < 2; ++vb)
#pragma unroll
            for (int rg = 0; rg < 4; ++rg) {
                u32x2 ov = {pk(oA[vb][4 * rg] * invA, oA[vb][4 * rg + 1] * invA), pk(oA[vb][4 * rg + 2] * invA, oA[vb][4 * rg + 3] * invA)};
                *(u32x2*)(dst + vb * 32 + rg * 8) = ov;
                u32x2 ow = {pk(oB[vb][4 * rg] * invB, oB[vb][4 * rg + 1] * invB), pk(oB[vb][4 * rg + 2] * invB, oB[vb][4 * rg + 3] * invB)};
                *(u32x2*)(dst + (size_t)32 * 1024 + vb * 32 + rg * 8) = ow;
            }
    }
}

constexpr int RST = 136;
DI void load_tile128(bf16_t* dstl, const bf16_t* src, size_t ld) {
    const int tid = threadIdx.x;
#pragma unroll
    for (int i = 0; i < 8; ++i) { const int idx = tid + 256 * i, r = idx >> 4, c8 = idx & 15;
        *(u32x4*)(dstl + r * RST + c8 * 8) = *(const u32x4*)(src + (size_t)r * ld + c8 * 8); }
}
DI void ret_u_phase(const Params& p, char* lds, int bid, int nb) {
    bf16_t* Vt = (bf16_t*)lds;
    bf16_t* Kt = Vt + 128 * RST;
    const int tid = threadIdx.x, lane = tid & 63, w = tid >> 6, l31 = lane & 31, h2 = lane >> 5;
    char* ws = p.ws;
    const bf16_t* RK = (const bf16_t*)(ws + A0_RK); const bf16_t* RVT = (const bf16_t*)(ws + A0_RVT);
    bf16_t* RUS = (bf16_t*)(ws + A0_RUS);
    for (int u = bid; u < NB * 4 * 66; u += nb) {
        const int c = u % 66, bh = u / 66, h = bh & 3, b = bh >> 2;
        const int g0 = b * TT + c * 128;
        load_tile128(Vt, RVT + ((size_t)(b * 4 + h) * 128) * TT + c * 128, TT);
        const int pos = tid & 127, half = tid >> 7;
        u32x4 kr[8];
        const bf16_t* ksrc = RK + (size_t)(g0 + pos) * 512 + h * 128 + half * 64;
#pragma unroll
        for (int i = 0; i < 8; ++i) kr[i] = *(const u32x4*)(ksrc + i * 8);
        for (int dir = 0; dir < 2; ++dir) {
            const float lg = p.ret_ld[dir * 4 + h];
            const float wgt = __expf(lg * (dir == 0 ? (float)(127 - pos) : (float)pos));
            if (dir == 1) __syncthreads();
#pragma unroll
            for (int i = 0; i < 8; ++i)
#pragma unroll
                for (int e = 0; e < 4; ++e) {
                    const unsigned uu = kr[i][e];
                    Kt[(half * 64 + i * 8 + 2 * e) * RST + pos] = f2bf(bflo(uu) * wgt);
                    Kt[(half * 64 + i * 8 + 2 * e + 1) * RST + pos] = f2bf(bfhi(uu) * wgt);
                }
            __syncthreads();
            f32x16 acc[4];
#pragma unroll
            for (int ni = 0; ni < 4; ++ni) zero16(acc[ni]);
            const bf16_t* Ac = Vt + (w * 32 + l31) * RST + h2 * 8;
            const bf16_t* Bc = Kt + l31 * RST + h2 * 8;
#pragma unroll
            for (int ks = 0; ks < 8; ++ks) {
                const s16x8 a = *(const s16x8*)(Ac + ks * 16);
#pragma unroll
                for (int ni = 0; ni < 4; ++ni) { const s16x8 bb = *(const s16x8*)(Bc + ni * 32 * RST + ks * 16); acc[ni] = MFMA32(a, bb, acc[ni]); }
            }
            bf16_t* dst = RUS + ((size_t)((b * 4 + h) * 2 + dir) * 66 + c) * 16384;
#pragma unroll
            for (int ni = 0; ni < 4; ++ni)
#pragma unroll
                for (int r = 0; r < 16; ++r) dst[(w * 32 + crow(r, h2)) * 128 + ni * 32 + l31] = f2bf(acc[ni][r]);
        }
        __syncthreads();
    }
}

DI void ret_scan_phase(const Params& p, int bid, int nb) {
    const unsigned tid = threadIdx.x;
    unsigned* RUS = (unsigned*)(p.ws + A0_RUS);
    for (int blk = bid; blk < 1024; blk += nb) {
        const int seq = blk >> 5;
        const unsigned e = (unsigned)(blk & 31) * 256u + tid;
        const int dir = seq & 1, h = (seq >> 1) & 3;
        const float g128 = __expf(p.ret_ld[dir * 4 + h] * 128.f);
        unsigned* sbase = RUS + (size_t)seq * 66 * 8192;
        float r0 = 0.f, r1 = 0.f;
#pragma unroll 1
        for (int hf = 0; hf < 2; ++hf) {
            unsigned v[33];
#pragma unroll
            for (int j = 0; j < 33; ++j) { const int i = hf * 33 + j; const int c = dir == 0 ? i : (i < 2 ? 1 - i : 67 - i); v[j] = (sbase + (size_t)c * 8192)[e]; }
#pragma unroll
            for (int j = 0; j < 33; ++j) {
                const int i = hf * 33 + j; const int c = dir == 0 ? i : (i < 2 ? 1 - i : 67 - i);
                (sbase + (size_t)c * 8192)[e] = pk(r0, r1);
                r0 = g128 * r0 + bflo(v[j]); r1 = g128 * r1 + bfhi(v[j]);
            }
        }
    }
}

DI void ret_out_phase(const Params& p, char* lds, int bid, int nb) {
    bf16_t* B0 = (bf16_t*)lds;
    bf16_t* Vt = B0 + 128 * RST;
    const int tid = threadIdx.x, lane = tid & 63, w = tid >> 6, l31 = lane & 31, h2 = lane >> 5;
    char* ws = p.ws;
    const bf16_t* RQ = (const bf16_t*)(ws + A0_RQ); const bf16_t* RK = (const bf16_t*)(ws + A0_RK); const bf16_t* RVT = (const bf16_t*)(ws + A0_RVT);
    const bf16_t* RG = (const bf16_t*)(ws + A0_RG); const bf16_t* RUS = (const bf16_t*)(ws + A0_RUS);
    bf16_t* MIX = (bf16_t*)(ws + O_H);
    for (int u = bid; u < NB * 4 * 66; u += nb) {
        const int c = u % 66, bh = u / 66, h = bh & 3, b = bh >> 2;
        const int g0 = b * TT + c * 128;
        const float lgf = p.ret_ld[h] * 1.4426950408889634f, lgb = p.ret_ld[4 + h] * 1.4426950408889634f;
        load_tile128(B0, RK + (size_t)g0 * 512 + h * 128, 512);
        load_tile128(Vt, RVT + ((size_t)(b * 4 + h) * 128) * TT + c * 128, TT);
        const int qi = w * 32 + l31;
        s16x8 qf[8];
        const bf16_t* Qg = RQ + (size_t)(g0 + qi) * 512 + h * 128 + h2 * 8;
#pragma unroll
        for (int ks = 0; ks < 8; ++ks) qf[ks] = *(const s16x8*)(Qg + ks * 16);
        __syncthreads();
        f32x16 o[4];
#pragma unroll
        for (int vb = 0; vb < 4; ++vb) zero16(o[vb]);
#pragma unroll 1
        for (int jb = 0; jb < 4; ++jb) {
            f32x16 s; zero16(s);
            const bf16_t* Kc = B0 + (jb * 32 + l31) * RST + h2 * 8;
#pragma unroll
            for (int ks = 0; ks < 8; ++ks) s = MFMA32(*(const s16x8*)(Kc + ks * 16), qf[ks], s);
#pragma unroll
            for (int r = 0; r < 16; ++r) {
                const int jj = jb * 32 + crow(r, h2); const int d = qi - jj;
                const float dm = d > 0 ? __builtin_amdgcn_exp2f(lgf * (float)d) : (d < 0 ? __builtin_amdgcn_exp2f(lgb * (float)(-d)) : 2.f);
                s[r] *= dm;
            }
#pragma unroll
            for (int sp = 0; sp < 2; ++sp) {
                const s16x8 pf = pack8(s[8 * sp], s[8 * sp + 1], s[8 * sp + 2], s[8 * sp + 3], s[8 * sp + 4], s[8 * sp + 5], s[8 * sp + 6], s[8 * sp + 7]);
                const int ko = jb * 32 + sp * 16 + 4 * h2;
#pragma unroll
                for (int vb = 0; vb < 4; ++vb) {
                    const bf16_t* vp = Vt + (vb * 32 + l31) * RST + ko;
                    o[vb] = MFMA32(cat4(*(const s16x4*)vp, *(const s16x4*)(vp + 8)), pf, o[vb]);
                }
            }
        }
#pragma unroll 1
        for (int dir = 0; dir < 2; ++dir) {
            __syncthreads();
            load_tile128(B0, RUS + ((size_t)((b * 4 + h) * 2 + dir) * 66 + c) * 16384, 128);
            const float dq = __builtin_amdgcn_exp2f((dir == 0 ? lgf * (float)(qi + 1) : lgb * (float)(128 - qi)));
            __syncthreads();
#pragma unroll
            for (int ks = 0; ks < 8; ++ks) {
                const u32x4 qq = __builtin_bit_cast(u32x4, qf[ks]);
                const s16x8 qs = pack8(bflo(qq[0]) * dq, bfhi(qq[0]) * dq, bflo(qq[1]) * dq, bfhi(qq[1]) * dq, bflo(qq[2]) * dq, bfhi(qq[2]) * dq, bflo(qq[3]) * dq, bfhi(qq[3]) * dq);
#pragma unroll
                for (int vb = 0; vb < 4; ++vb) o[vb] = MFMA32(*(const s16x8*)(B0 + (vb * 32 + l31) * RST + h2 * 8 + ks * 16), qs, o[vb]);
            }
        }
        float sm = 0.f;
#pragma unroll
        for (int vb = 0; vb < 4; ++vb)
#pragma unroll
            for (int r = 0; r < 16; ++r) sm += o[vb][r];
        sm += __shfl_xor(sm, 32);
        const float mu = sm * (1.f / 128.f); float q = 0.f;
#pragma unroll
        for (int vb = 0; vb < 4; ++vb)
#pragma unroll
            for (int r = 0; r < 16; ++r) { o[vb][r] -= mu; q += o[vb][r] * o[vb][r]; }
        q += __shfl_xor(q, 32);
        const float rstd = rsqrtf(q * (1.f / 128.f) + EPS);
        const bf16_t* gsrc = RG + (size_t)(g0 + qi) * 512 + h * 128 + 4 * h2;
        bf16_t* dst = MIX + (size_t)(g0 + qi) * 1024 + 512 + h * 128 + 4 * h2;
#pragma unroll
        for (int vb = 0; vb < 4; ++vb)
#pragma unroll
            for (int rg = 0; rg < 4; ++rg) {
                const u32x2 gg = *(const u32x2*)(gsrc + vb * 32 + rg * 8);
                const float g0v = siluf(bflo(gg[0])), g1v = siluf(bfhi(gg[0])), g2v = siluf(bflo(gg[1])), g3v = siluf(bfhi(gg[1]));
                u32x2 ov = {pk(g0v * o[vb][4 * rg] * rstd, g1v * o[vb][4 * rg + 1] * rstd), pk(g2v * o[vb][4 * rg + 2] * rstd, g3v * o[vb][4 * rg + 3] * rstd)};
                *(u32x2*)(dst + vb * 32 + rg * 8) = ov;
            }
        __syncthreads();
    }
}

DI void mconv_phase(const Params& p, int bid, int nb) {
    const int tid = threadIdx.x; const int gtid = bid * NTHR + tid, gthreads = nb * NTHR;
    const float* HALO = (const float*)(p.ws + A1_HALO);
    bf16_t* POST = (bf16_t*)(p.ws + A1_QKPRE);
    for (int it = gtid; it < (RT / 128) * 2 * 256; it += gthreads) {
        const int c4 = (it & 255) * 4, which = (it >> 8) & 1, hidx = it >> 9;
        const int hb = hidx % 66;
        const float* hh = HALO + (size_t)hidx * 4 * 1024 + c4;
        const f32x4 z = {0.f, 0.f, 0.f, 0.f};
        f32x4 xm, x0, xp; int row;
        if (which == 0) { row = 0; x0 = *(const f32x4*)hh; xp = *(const f32x4*)(hh + 1024); xm = (hb == 0 || hb == 2) ? z : *(const f32x4*)(hh - 4 * 1024 + 3 * 1024); }
        else { row = 127; xm = *(const f32x4*)(hh + 2 * 1024); x0 = *(const f32x4*)(hh + 3 * 1024); xp = (hb == 1 || hb == 65) ? z : *(const f32x4*)(hh + 4 * 1024); }
        const f32x4 w0 = *(const f32x4*)(p.m_conv_w + c4), w1 = *(const f32x4*)(p.m_conv_w + 1024 + c4), w2 = *(const f32x4*)(p.m_conv_w + 2048 + c4), bb = *(const f32x4*)(p.m_conv_b + c4);
        const float scl = c4 >= 512 ? 0.125f : 1.f;
        const f32x4 a = xm * w0 + x0 * w1 + xp * w2 + bb;
        u32x2 o = {pk(siluf(a[0]) * scl, siluf(a[1]) * scl), pk(siluf(a[2]) * scl, siluf(a[3]) * scl)};
        *(u32x2*)(POST + (size_t)(hidx * 128 + row) * 1024 + c4) = o;
    }
}

constexpr int MST = 72;
DI void mlstm_u_phase(const Params& p, char* lds, int bid, int nb) {
    bf16_t* Vt = (bf16_t*)lds;
    bf16_t* Ktf = Vt + 128 * MST;
    bf16_t* Ktb = Ktf + 64 * MST;
    float* gt = (float*)(Ktb + 64 * MST);
    float* wt = gt + 256; float* scal = wt + 128;
    const int tid = threadIdx.x, lane = tid & 63, w = tid >> 6, l31 = lane & 31, h2 = lane >> 5;
    char* ws = p.ws;
    const bf16_t* QK = (const bf16_t*)(ws + A1_QKPRE); const bf16_t* MVT = (const bf16_t*)(ws + A1_VT); const float* MG = (const float*)(ws + A1_G);
    bf16_t* MU = (bf16_t*)(ws + A1_U); float* MN = (float*)(ws + A1_N); float* MSC = (float*)(ws + A1_SC);
    for (int u = bid; u < NB * 8 * 132; u += nb) {
        const int c = u % 132, bh = u / 132, h = bh & 7, b = bh >> 3;
        const int g0 = b * TT + c * 64;
        { const int kind = tid >> 6, s = tid & 63; gt[kind * 64 + s] = MG[(size_t)(g0 + s) * 32 + kind * 8 + h]; }
#pragma unroll
        for (int i = 0; i < 4; ++i) { const int idx = tid + 256 * i, r = idx >> 3, c8 = idx & 7;
            *(u32x4*)(Vt + r * MST + c8 * 8) = *(const u32x4*)(MVT + ((size_t)(b * 8 + h) * 128 + r) * TT + c * 64 + c8 * 8); }
        const int pos = tid & 63, qd = tid >> 6;
        const bf16_t* ksrc = QK + (size_t)(g0 + pos) * 1024 + 512 + h * 64 + qd * 16;
        const u32x4 k0 = *(const u32x4*)ksrc, k1 = *(const u32x4*)(ksrc + 8);
        __syncthreads();
        if (tid < 2) {
            if (tid == 0) {
                float run = 0.f, mx = -1e30f;
                for (int s = 63; s >= 0; --s) { const float lw = run + gt[s]; wt[s] = lw; mx = fmaxf(mx, lw); run += gt[64 + s]; }
                scal[0] = mx; scal[1] = run;
            } else {
                float run = 0.f, mx = -1e30f;
                for (int s = 0; s < 64; ++s) { const float lw = run + gt[128 + s]; wt[64 + s] = lw; mx = fmaxf(mx, lw); run += gt[192 + s]; }
                scal[2] = mx; scal[3] = run;
            }
        }
        __syncthreads();
        const float wf = __expf(wt[pos] - scal[0]), wb = __expf(wt[64 + pos] - scal[2]);
#pragma unroll
        for (int e = 0; e < 4; ++e) {
            const int dk = qd * 16 + 2 * e;
            Ktf[dk * MST + pos] = f2bf(bflo(k0[e]) * wf); Ktf[(dk + 1) * MST + pos] = f2bf(bfhi(k0[e]) * wf);
            Ktf[(dk + 8) * MST + pos] = f2bf(bflo(k1[e]) * wf); Ktf[(dk + 9) * MST + pos] = f2bf(bfhi(k1[e]) * wf);
            Ktb[dk * MST + pos] = f2bf(bflo(k0[e]) * wb); Ktb[(dk + 1) * MST + pos] = f2bf(bfhi(k0[e]) * wb);
            Ktb[(dk + 8) * MST + pos] = f2bf(bflo(k1[e]) * wb); Ktb[(dk + 9) * MST + pos] = f2bf(bfhi(k1[e]) * wb);
        }
        __syncthreads();
        const size_t sidx0 = (size_t)((b * 8 + h) * 2) * 132 + c;
        if (tid < 128) {
            const int dir = tid >> 6, dk = tid & 63; const bf16_t* row = (dir ? Ktb : Ktf) + dk * MST; float s = 0.f;
            for (int i = 0; i < 64; ++i) s += bf2f(row[i]);
            MN[(sidx0 + dir * 132) * 64 + dk] = s;
        } else if (tid < 130) {
            const int dir = tid - 128;
            MSC[(sidx0 + dir * 132) * 4 + 0] = scal[dir * 2]; MSC[(sidx0 + dir * 132) * 4 + 1] = scal[dir * 2 + 1];
        }
#pragma unroll 1
        for (int dir = 0; dir < 2; ++dir) {
            f32x16 acc[2]; zero16(acc[0]); zero16(acc[1]);
            const bf16_t* Ac = Vt + (w * 32 + l31) * MST + h2 * 8;
            const bf16_t* Bc = (dir ? Ktb : Ktf) + l31 * MST + h2 * 8;
#pragma unroll
            for (int ks = 0; ks < 4; ++ks) {
                const s16x8 a = *(const s16x8*)(Ac + ks * 16);
                acc[0] = MFMA32(a, *(const s16x8*)(Bc + ks * 16), acc[0]); acc[1] = MFMA32(a, *(const s16x8*)(Bc + 32 * MST + ks * 16), acc[1]);
            }
            bf16_t* dst = MU + (sidx0 + dir * 132) * 8192;
#pragma unroll
            for (int ni = 0; ni < 2; ++ni)
#pragma unroll
                for (int r = 0; r < 16; ++r) dst[(w * 32 + crow(r, h2)) * 64 + ni * 32 + l31] = f2bf(acc[ni][r]);
        }
        __syncthreads();
    }
}

DI int mchunk(int dir, int i) { return dir == 0 ? i : (i < 4 ? 3 - i : 135 - i); }
DI void mlstm_scan_phase(const Params& p, char* lds, int bid, int nb) {
    const int tid = threadIdx.x;
    unsigned* MU = (unsigned*)(p.ws + A1_U); float* MN = (float*)(p.ws + A1_N); float* MSC = (float*)(p.ws + A1_SC);
    float* la = (float*)lds;
    float* lu = la + 132;
    float* lml = lu + 132;
    float* lbe = lml + 132;
    for (int blk = bid; blk < 1024; blk += nb) {
        const int seq = blk >> 4;
        const int part = blk & 15;
        const int e = part * 256 + tid; const int dir = seq & 1;
        float* sc = MSC + (size_t)seq * 132 * 4;
        if (tid < 132) { const int c = mchunk(dir, tid); lml[tid] = sc[c * 4]; lbe[tid] = sc[c * 4 + 1]; }
        __syncthreads();
        if (tid == 0) {
            float m = 0.f;
            for (int i = 0; i < 132; ++i) {
                const float mloc = lml[i], bend = lbe[i];
                const float mnew = fmaxf(bend + m, mloc);
                la[i] = __expf(bend + m - mnew); lu[i] = __expf(mloc - mnew);
                if (part == 0) sc[mchunk(dir, i) * 4 + 2] = m;
                m = mnew;
            }
        }
        __syncthreads();
        unsigned* sbase = MU + (size_t)seq * 132 * 4096;
        const unsigned eu = (unsigned)e;
        float r0 = 0.f, r1 = 0.f;
#pragma unroll 1
        for (int hf = 0; hf < 4; ++hf) {
            unsigned v[33];
#pragma unroll
            for (int j = 0; j < 33; ++j) v[j] = (sbase + (size_t)mchunk(dir, hf * 33 + j) * 4096)[eu];
#pragma unroll
            for (int j = 0; j < 33; ++j) {
                const int i = hf * 33 + j;
                (sbase + (size_t)mchunk(dir, i) * 4096)[eu] = pk(r0, r1);
                const float a = la[i], uw = lu[i];
                r0 = a * r0 + uw * bflo(v[j]); r1 = a * r1 + uw * bfhi(v[j]);
            }
        }
        if (part == 1 && tid < 64) {
            float* nbase = MN + (size_t)seq * 132 * 64; float rn = 0.f; const unsigned tu = (unsigned)tid;
#pragma unroll 1
            for (int hf = 0; hf < 4; ++hf) {
                float v[33];
#pragma unroll
                for (int j = 0; j < 33; ++j) v[j] = (nbase + (size_t)mchunk(dir, hf * 33 + j) * 64)[tu];
#pragma unroll
                for (int j = 0; j < 33; ++j) { const int i = hf * 33 + j; (nbase + (size_t)mchunk(dir, i) * 64)[tu] = rn; rn = la[i] * rn + lu[i] * v[j]; }
            }
        }
        __syncthreads();
    }
}

DI void mlstm_out_phase(const Params& p, char* lds, int bid, int nb) {
    bf16_t* Qs = (bf16_t*)lds;
    bf16_t* Ks = Qs + 64 * MST;
    bf16_t* Vt = Ks + 64 * MST;
    bf16_t* Cf = Vt + 128 * MST;
    bf16_t* Cb = Cf + 128 * MST;
    float* HX = (float*)lds;
    float* tb = (float*)(lds + 73728);
    float* tn = tb + 384; float* gt = tn + 128;
    constexpr int HST = 68;
    const int tid = threadIdx.x, lane = tid & 63, w = tid >> 6, l31 = lane & 31, h2 = lane >> 5;
    char* ws = p.ws;
    const bf16_t* QK = (const bf16_t*)(ws + A1_QKPRE); const bf16_t* MVT = (const bf16_t*)(ws + A1_VT); const float* MG = (const float*)(ws + A1_G);
    const bf16_t* MU = (const bf16_t*)(ws + A1_U); const float* MN = (const float*)(ws + A1_N); const float* MSC = (const float*)(ws + A1_SC);
    const bf16_t* OG = (const bf16_t*)(ws + A1_OG); bf16_t* MIXM = (bf16_t*)(ws + O_H);
    u32x4 pq[2], pk_[2], pv[4], pcf[4], pcb[4]; float pg = 0.f, pn = 0.f, pmc = 0.f;
#define MO_LOAD(U) { int tl = threadIdx.x; asm volatile("" : "+v"(tl)); const int cl_ = (U) & 127, bh_ = (U) >> 7, h_ = bh_ & 7, b_ = bh_ >> 3; const int c_ = cl_ + 4; const int g0_ = b_ * TT + c_ * 64; \
        const size_t si_ = (size_t)((b_ * 8 + h_) * 2) * 132 + c_; \
        pg = MG[(size_t)(g0_ + (tl & 63)) * 32 + (tl >> 6) * 8 + h_]; \
        pn = MN[(si_ + ((tl >> 6) & 1) * 132) * 64 + (tl & 63)]; \
        pmc = MSC[(si_ + (tl >> 7) * 132) * 4 + 2]; \
        _Pragma("unroll") for (int i = 0; i < 2; ++i) { const int idx = tl + 256 * i, r = idx >> 3, c8 = idx & 7; \
            pq[i] = *(const u32x4*)(QK + (size_t)(g0_ + r) * 1024 + h_ * 64 + c8 * 8); \
            pk_[i] = *(const u32x4*)(QK + (size_t)(g0_ + r) * 1024 + 512 + h_ * 64 + c8 * 8); } \
        _Pragma("unroll") for (int i = 0; i < 4; ++i) { const int idx = tl + 256 * i, r = idx >> 3, c8 = idx & 7; \
            pv[i] = *(const u32x4*)(MVT + ((size_t)(b_ * 8 + h_) * 128 + r) * TT + c_ * 64 + c8 * 8); \
            pcf[i] = *(const u32x4*)(MU + si_ * 8192 + r * 64 + c8 * 8); \
            pcb[i] = *(const u32x4*)(MU + (si_ + 132) * 8192 + r * 64 + c8 * 8); } }
    if (bid < NB * 8 * 128) MO_LOAD(bid)
    for (int u = bid; u < NB * 8 * 128; u += nb) {
        const int cl = u & 127, bh = u >> 7, h = bh & 7, b = bh >> 3; const int c = cl + 4;
        const int g0 = b * TT + c * 64;
        const size_t sidx0 = (size_t)((b * 8 + h) * 2) * 132 + c;
        int tl2 = threadIdx.x; asm volatile("" : "+v"(tl2));
        gt[tl2] = pg;
        if (tl2 < 128) tn[tl2] = pn;
        const float mc_pre = pmc;
        u32x4 ogpre[4];
        { const bf16_t* ogp = OG + (size_t)(g0 + (tl2 >> 2)) * 1024 + h * 128 + (tl2 & 3) * 32;
#pragma unroll
          for (int i = 0; i < 4; ++i) ogpre[i] = *(const u32x4*)(ogp + i * 8); }
#pragma unroll
        for (int i = 0; i < 2; ++i) { const int idx = tl2 + 256 * i, r = idx >> 3, c8 = idx & 7;
            *(u32x4*)(Qs + r * MST + c8 * 8) = pq[i]; *(u32x4*)(Ks + r * MST + c8 * 8) = pk_[i]; }
#pragma unroll
        for (int i = 0; i < 4; ++i) { const int idx = tl2 + 256 * i, r = idx >> 3, c8 = idx & 7;
            *(u32x4*)(Vt + r * MST + c8 * 8) = pv[i]; *(u32x4*)(Cf + r * MST + c8 * 8) = pcf[i]; *(u32x4*)(Cb + r * MST + c8 * 8) = pcb[i]; }
        __syncthreads();
        if (w < 2) {
            const int sidx = lane;
            float run = gt[(w == 0 ? 64 : 192) + sidx];
            const float gi = gt[(w == 0 ? 0 : 128) + sidx];
            if (w == 0) {
#pragma unroll
                for (int o = 1; o < 64; o <<= 1) { const float v = __shfl_up(run, o); if (lane >= o) run += v; }
            } else {
#pragma unroll
                for (int o = 1; o < 64; o <<= 1) { const float v = __shfl_down(run, o); if (lane + o < 64) run += v; }
            }
            const float a = gi - run; float mx = a;
            if (w == 0) {
#pragma unroll
                for (int o = 1; o < 64; o <<= 1) { const float v = __shfl_up(mx, o); if (lane >= o) mx = fmaxf(mx, v); }
            } else {
#pragma unroll
                for (int o = 1; o < 64; o <<= 1) { const float v = __shfl_down(mx, o); if (lane + o < 64) mx = fmaxf(mx, v); }
            }
            float* T0 = tb + w * 192;
            T0[sidx] = run; T0[64 + sidx] = a; T0[128 + sidx] = mx;
        }
        __syncthreads();
        const int dir = w >> 1, tq = (w & 1) * 32 + l31;
        const float* T = tb + dir * 192;
        const float mc = mc_pre;
        const float bq = T[tq]; const float mt = bq + fmaxf(mc, T[128 + tq]);
        const float et = bq - mt; const float winter = __expf(bq + mc - mt);
        s16x8 qf[4];
#pragma unroll
        for (int ks = 0; ks < 4; ++ks) qf[ks] = *(const s16x8*)(Qs + tq * MST + ks * 16 + h2 * 8);
        f32x16 acc[4];
#pragma unroll
        for (int vb = 0; vb < 4; ++vb) zero16(acc[vb]);
        const bf16_t* Cc = (dir ? Cb : Cf) + l31 * MST + h2 * 8;
#pragma unroll
        for (int ks = 0; ks < 4; ++ks)
#pragma unroll
            for (int vb = 0; vb < 4; ++vb) acc[vb] = MFMA32(*(const s16x8*)(Cc + vb * 32 * MST + ks * 16), qf[ks], acc[vb]);
#pragma unroll
        for (int vb = 0; vb < 4; ++vb)
#pragma unroll
            for (int r = 0; r < 16; ++r) acc[vb][r] *= winter;
        float qn = 0.f;
        { const float* nv = tn + dir * 64 + h2 * 32; const bf16_t* qr = Qs + tq * MST + h2 * 32;
#pragma unroll
          for (int d = 0; d < 32; d += 2) { const unsigned uu = *(const unsigned*)(qr + d); qn += bflo(uu) * nv[d] + bfhi(uu) * nv[d + 1]; } }
        qn += __shfl_xor(qn, 32);
        float den = 0.f;
        f32x16 s[2]; zero16(s[0]); zero16(s[1]);
        const bf16_t* Kc = Ks + l31 * MST + h2 * 8;
#pragma unroll
        for (int ks = 0; ks < 4; ++ks) { s[0] = MFMA32(*(const s16x8*)(Kc + ks * 16), qf[ks], s[0]); s[1] = MFMA32(*(const s16x8*)(Kc + 32 * MST + ks * 16), qf[ks], s[1]); }
#pragma unroll
        for (int sb = 0; sb < 2; ++sb)
#pragma unroll
            for (int r = 0; r < 16; ++r) {
                const int sp = sb * 32 + crow(r, h2);
                const bool ok = dir == 0 ? (sp <= tq) : (sp >= tq);
                const float g = ok ? __expf(et + T[64 + sp]) : 0.f;
                s[sb][r] *= g; den += s[sb][r];
            }
        den += __shfl_xor(den, 32);
        den += winter * qn;
#pragma unroll
        for (int sb = 0; sb < 2; ++sb)
#pragma unroll
            for (int sp = 0; sp < 2; ++sp) {
                const s16x8 pf = pack8(s[sb][8 * sp], s[sb][8 * sp + 1], s[sb][8 * sp + 2], s[sb][8 * sp + 3], s[sb][8 * sp + 4], s[sb][8 * sp + 5], s[sb][8 * sp + 6], s[sb][8 * sp + 7]);
                const int ko = sb * 32 + sp * 16 + 4 * h2;
#pragma unroll
                for (int vb = 0; vb < 4; ++vb) {
                    const bf16_t* vp = Vt + (vb * 32 + l31) * MST + ko;
                    acc[vb] = MFMA32(cat4(*(const s16x4*)vp, *(const s16x4*)(vp + 8)), pf, acc[vb]);
                }
            }
        const float hden = __builtin_amdgcn_rcpf(fmaxf(fabsf(den), __expf(-mt)));
        __syncthreads();
#pragma unroll
        for (int vb = 0; vb < 4; ++vb)
#pragma unroll
            for (int r = 0; r < 16; ++r) HX[(dir * 128 + vb * 32 + crow(r, h2)) * HST + tq] = acc[vb][r] * hden;
        __builtin_amdgcn_sched_barrier(0);
        if (u + nb < NB * 8 * 128) MO_LOAD(u + nb)
        __builtin_amdgcn_sched_barrier(0);
        __syncthreads();
        {
            const int t = tid >> 2, q4 = tid & 3;
            float hv[32]; float sm = 0.f;
#pragma unroll
            for (int i = 0; i < 32; ++i) { const int dv = q4 * 32 + i; hv[i] = HX[dv * HST + t] + HX[(128 + dv) * HST + t]; sm += hv[i]; }
            sm += __shfl_xor(sm, 1); sm += __shfl_xor(sm, 2);
            const float mu = sm * (1.f / 128.f); float q = 0.f;
#pragma unroll
            for (int i = 0; i < 32; ++i) { hv[i] -= mu; q += hv[i] * hv[i]; }
            q += __shfl_xor(q, 1); q += __shfl_xor(q, 2);
            const float rstd = rsqrtf(q * (1.f / 128.f) + EPS);
            const bf16_t* og = OG + (size_t)(g0 + t) * 1024 + h * 128 + q4 * 32;
            bf16_t* mixo = MIXM + (size_t)(g0 + t) * 1024 + h * 128 + q4 * 32;
            const float* ng = p.m_norm_g + h * 128 + q4 * 32;
#pragma unroll
            for (int i = 0; i < 4; ++i) {
                const u32x4 gg = ogpre[i];
                float y[8];
#pragma unroll
                for (int e = 0; e < 4; ++e) {
                    y[2 * e] = sigmf(bflo(gg[e])) * hv[i * 8 + 2 * e] * rstd * ng[i * 8 + 2 * e];
                    y[2 * e + 1] = sigmf(bfhi(gg[e])) * hv[i * 8 + 2 * e + 1] * rstd * ng[i * 8 + 2 * e + 1];
                }
                u32x4 ov = {pk(y[0], y[1]), pk(y[2], y[3]), pk(y[4], y[5]), pk(y[6], y[7])};
                *(u32x4*)(mixo + i * 8) = ov;
            }
        }
        __syncthreads();
    }
}


#undef MO_LOAD
#define XB_TMO      128
#define XB_XCNT(j)  (256  + 64 * (j))
#define XB_XSUB(j)  (1280 + 64 * (j))
#define XB_XGEN(j)  (2304 + 64 * (j))
#define XB_TOP      3328
#define XB_TOPGEN   3392
#define XCD_BAR_WORDS 3456
#define XB_SPIN_CAP (1u << 18)
#define LAS __attribute__((address_space(3)))
DI unsigned xb_ld(unsigned* p)              { return __hip_atomic_load(p, __ATOMIC_RELAXED, __HIP_MEMORY_SCOPE_AGENT); }
DI unsigned xb_add(unsigned* p, unsigned v) { return __hip_atomic_fetch_add(p, v, __ATOMIC_RELAXED, __HIP_MEMORY_SCOPE_AGENT); }
DI unsigned xb_xcc_id() { return (unsigned)__builtin_amdgcn_s_getreg((3 << 11) | 20) & 0xFu; }
#define XB_SPIN(cond, bar) do { unsigned _sp = 0; while (cond) { __builtin_amdgcn_s_sleep(1); \
    if ((++_sp & 255u) == 0u) { if (xb_ld(&(bar)[XB_TMO])) break; if (_sp > XB_SPIN_CAP) { atomicAdd(&(bar)[XB_TMO], 1u); break; } } } } while (0)
struct XcdBarrier { unsigned* bar; unsigned x; volatile LAS unsigned* st; };
DI XcdBarrier xcd_barrier_post(unsigned* bar, volatile LAS unsigned* st) {
    XcdBarrier b; b.bar = bar; b.x = xb_xcc_id(); b.st = st;
    if (threadIdx.x == 0) (void)xb_add(&bar[XB_XCNT(b.x)], 1u);
    return b;
}
DI void xcd_barrier_complete(unsigned* bar, unsigned x, unsigned& nloc, unsigned& nx) {
    const unsigned G = gridDim.x * gridDim.y * gridDim.z;
    unsigned sum, cnt, mine, sp = 0u;
    for (;;) {
        sum = 0u; cnt = 0u; mine = 0u;
#pragma unroll
        for (unsigned j = 0; j < 16; ++j) { const unsigned c = xb_ld(&bar[XB_XCNT(j)]); sum += c; cnt += (c > 0u) ? 1u : 0u; mine = (j == x) ? c : mine; }
        if (sum == G) break;
        __builtin_amdgcn_s_sleep(1);
        if ((++sp & 255u) == 0u) { if (xb_ld(&bar[XB_TMO])) break; if (sp > XB_SPIN_CAP) { atomicAdd(&bar[XB_TMO], 1u); break; } }
    }
    nloc = mine > 0u ? mine : 1u; nx = cnt > 0u ? cnt : 1u;
}
DI void xcd_barrier(const XcdBarrier& b) {
    asm volatile("s_waitcnt vmcnt(0)" ::: "memory");
    __syncthreads();
    if (threadIdx.x == 0) {
        unsigned* bar = b.bar;
        __builtin_amdgcn_s_waitcnt(0);
        unsigned nloc = b.st[0], nx = b.st[1];
        if (nloc == 0u) { xcd_barrier_complete(bar, b.x, nloc, nx); b.st[0] = nloc; b.st[1] = nx; }
        const unsigned old = xb_add(&bar[XB_XSUB(b.x)], 1u);
        const unsigned gen = old / nloc;
        if (old + 1u == (gen + 1u) * nloc) {
            __builtin_amdgcn_fence(__ATOMIC_RELEASE, "agent");
            asm volatile("s_waitcnt vmcnt(0)" ::: "memory");
            const unsigned og = xb_add(&bar[XB_TOP], 1u);
            const unsigned tg = og / nx;
            if (og + 1u == (tg + 1u) * nx) xb_add(&bar[XB_TOPGEN], 1u);
            else XB_SPIN(xb_ld(&bar[XB_TOPGEN]) == tg, bar);
            __builtin_amdgcn_fence(__ATOMIC_ACQUIRE, "agent");
            xb_add(&bar[XB_XGEN(b.x)], 1u);
            asm volatile("s_waitcnt vmcnt(0)" ::: "memory");
        } else {
            XB_SPIN(xb_ld(&bar[XB_XGEN(b.x)]) == gen, bar);
            __builtin_amdgcn_fence(__ATOMIC_ACQUIRE, "agent");
            asm volatile("s_waitcnt vmcnt(0)" ::: "memory");
        }
    }
    __syncthreads();
}

constexpr int NPHASE = 21;
__global__ void __launch_bounds__(NTHR, 2) fwd_kernel(Params p) {
    extern __shared__ __attribute__((aligned(16))) char lds[];
    const int bid = blockIdx.x, nb = gridDim.x;
    char* ws = p.ws;
#if !MULTI_LAUNCH
    cg::grid_group grid = cg::this_grid();
    if (p.ph_hi > 1000) grid.sync();
    volatile LAS unsigned* xst = (volatile LAS unsigned*)(LAS char*)(lds + LDS_BYTES - 16);
    if (threadIdx.x == 0) { xst[0] = 0u; xst[1] = 0u; }
    __syncthreads();
    XcdBarrier xbar = xcd_barrier_post((unsigned*)(ws + O_BAR), xst);
#define SYNC() xcd_barrier(xbar)
#else
#define SYNC() do {} while (0)
#endif
#ifdef ONLY_PHASE
#define PHON(n) ((n) == ONLY_PHASE)
#else
#define PHON(n) true
#endif
#ifndef DUP_MASK
#define DUP_MASK 0u
#endif
#define PHASE(n, ...) if constexpr (PHON(n)) { if (p.ph_lo <= (n) && (n) < p.ph_hi) { if ((n) > p.ph_lo) SYNC(); __VA_ARGS__ if constexpr (((DUP_MASK >> (n)) & 1u) != 0u) { SYNC(); __VA_ARGS__ } } }
    PHASE(0, phase_prologue(p, lds, bid, nb);)
    PHASE(1, phase_modulate0(p, bid, nb);)
    PHASE(2, { GemmArgs ga{(const bf16_t*)(ws + O_H), 1024, (const bf16_t*)(ws + W_ABIN), 1024, 1024, RT / 256, 22, 0, 1}; EpiAbIn e{p}; gemm_phase(ga, e, lds, bid, nb); })
    PHASE(3, {
            GemmArgs g1{(const bf16_t*)(ws + A0_CQ), 384, (const bf16_t*)(ws + W_UQ), 384, 384, RT / 256, 6, 0, 1}; EpiUq e1{p}; gemm_phase(g1, e1, lds, bid, nb);
            GemmArgs g2{(const bf16_t*)(ws + A0_CKV), 256, (const bf16_t*)(ws + W_UKV), 256, 256, RT / 256, 8, 0, 1}; EpiUkv e2{p}; gemm_phase(g2, e2, lds, bid, nb);
            ret_u_phase(p, lds, bid, nb);
        })
    PHASE(4, ret_scan_phase(p, bid, nb);)
    PHASE(5, { attn_phase(p, lds, bid, nb); ret_out_phase(p, lds, bid, nb); })
    PHASE(6, { GemmArgs ga{(const bf16_t*)(ws + O_H), 1024, (const bf16_t*)(ws + W_ABOUT), 1024, 1024, 128, 8, 1, 1}; EpiResid e{p, 0, 2, 1, 0, 0, 0, 0}; gemm_phase(ga, e, lds, bid, nb);
        GemmArgs gc{(const bf16_t*)(ws + O_H), 1024, (const bf16_t*)(ws + W_ABOUT), 1024, 1024, 4, 8, 2, 16}; EpiResid ec{p, 0, 2, 1, 1, 0, 0, 0}; gemm_phase(gc, ec, lds, bid, nb); })
    PHASE(7, ln_phase(p, 0, 0, 0, 3, 0, bid, nb, 16, 2, 1, 1, 0);)
    PHASE(8, { GemmArgs ga{(const bf16_t*)(ws + O_H), 1024, (const bf16_t*)(ws + W_FFIN), 1024, 1024, RT / 256, 44, 0, 1}; EpiFfIn e{p}; gemm_phase(ga, e, lds, bid, nb); })
    PHASE(9, { GemmArgs ga{(const bf16_t*)(ws + O_ACT), DFF, (const bf16_t*)(ws + W_FFOUT), DFF, DFF, 128, 8, 1, 1}; EpiResid e{p, 0, 5, 0, 0, 1, 0, 0}; gemm_phase(ga, e, lds, bid, nb);
        GemmArgs gc{(const bf16_t*)(ws + O_ACT), DFF, (const bf16_t*)(ws + W_FFOUT), DFF, DFF, 4, 8, 2, 11}; EpiResid ec{p, 0, 5, 0, 1, 0, 0, 0}; gemm_phase(gc, ec, lds, bid, nb); })
    PHASE(10, ln_phase(p, 0, 1, 1, 0, 0, bid, nb, 11, 5, 0, 2, 1);)
    PHASE(11, { GemmArgs ga{(const bf16_t*)(ws + O_H), 1024, (const bf16_t*)(ws + W_MIN), 1024, 1024, RT / 256, 25, 0, 1}; EpiMIn e{p}; gemm_phase(ga, e, lds, bid, nb); })
    PHASE(12, mconv_phase(p, bid, nb);)
    PHASE(13, mlstm_u_phase(p, lds, bid, nb);)
    PHASE(14, mlstm_scan_phase(p, lds, bid, nb);)
    PHASE(15, mlstm_out_phase(p, lds, bid, nb);)
    PHASE(16, { GemmArgs ga{(const bf16_t*)(ws + O_H), 1024, (const bf16_t*)(ws + W_MOUT), 1024, 1024, 128, 8, 1, 1}; EpiResid e{p, 1, 2, 0, 0, 2, 0, 1}; gemm_phase(ga, e, lds, bid, nb); })
    PHASE(17, ln_phase(p, 1, 0, 1, 3, 1, bid, nb, 0, 0, 0, 3);)
    PHASE(18, { GemmArgs ga{(const bf16_t*)(ws + O_H), 1024, (const bf16_t*)(ws + W_FFIN) + (size_t)5632 * 1024, 1024, 1024, 128, 44, 1, 1}; EpiFfIn e{p}; gemm_phase(ga, e, lds, bid, nb); })
    PHASE(19, { GemmArgs ga{(const bf16_t*)(ws + O_ACT), DFF, (const bf16_t*)(ws + W_FFOUT) + (size_t)1024 * 2816, DFF, DFF, 128, 8, 1, 1}; EpiResid e{p, 1, 5, 0, 0, 3, 1, 0}; gemm_phase(ga, e, lds, bid, nb); })
    PHASE(20, ln_phase(p, 1, 1, 1, -1, 1, bid, nb);)
}

extern "C" void kernel_launch(void* const* d_in, const int* in_sizes, int n_in, void* d_out, int out_size, void* d_ws, size_t ws_size, hipStream_t stream) {
    static int grid_blocks = 0;
    if (!grid_blocks) {
        int dev = 0, cus = 0, per_cu = 0;
        hipGetDevice(&dev);
        hipDeviceGetAttribute(&cus, hipDeviceAttributeMultiprocessorCount, dev);
        hipFuncSetAttribute((const void*)fwd_kernel, hipFuncAttributeMaxDynamicSharedMemorySize, LDS_BYTES);
        hipOccupancyMaxActiveBlocksPerMultiprocessor(&per_cu, (const void*)fwd_kernel, NTHR, LDS_BYTES);
        if (per_cu < 1) per_cu = 1;
        if (per_cu > 2) per_cu = 2;
        grid_blocks = cus * per_cu;
        if (ws_size < WS_NEED) fprintf(stderr, "kernel_launch: workspace too small: %zu < %zu\n", ws_size, (size_t)WS_NEED);
    }
    Params p{};
    const float** f = (const float**)&p;
    for (int i = 0; i < 23; ++i) f[i] = (const float*)d_in[i];
    p.out = (float*)d_out; p.ws = (char*)d_ws;
#if !MULTI_LAUNCH
    p.ph_lo = 0; p.ph_hi = NPHASE;
    (void)hipMemsetAsync((char*)d_ws + O_BAR, 0, 16384, stream);
    void* args[] = {&p};
    hipError_t e = hipLaunchCooperativeKernel((const void*)fwd_kernel, dim3(grid_blocks), dim3(NTHR), args, LDS_BYTES, stream);
    if (e != hipSuccess) fprintf(stderr, "cooperative launch failed: %s (grid %d)\n", hipGetErrorString(e), grid_blocks);
#else
    for (int ph = 0; ph < NPHASE; ++ph) {
        p.ph_lo = ph; p.ph_hi = ph + 1;
        hipLaunchKernelGGL(fwd_kernel, dim3(grid_blocks), dim3(NTHR), LDS_BYTES, stream, p);
    }
#endif
}
```
